# Optimizing an MI355X kernel written in HIP

```python
import math
import jax, jax.numpy as jnp
from jax import lax
import numpy as np

D_MODEL = 1024
BATCH = 2
SEQ = 8192
DEPTH = 2
DEC_BATCH = 1
DEC_SEQ = 16384
PAST_LEN = 128

MIX_WIDTH = D_MODEL
FOURIER_WIDTH = MIX_WIDTH // 2
N_FGROUPS = 4
FGROUP = FOURIER_WIDTH // N_FGROUPS
ATT_WIDTH = MIX_WIDTH - FOURIER_WIDTH
HEAD_DIM = 64
N_HEADS = ATT_WIDTH // HEAD_DIM
IN_WIDTH = FOURIER_WIDTH + 3 * ATT_WIDTH
GRID_W = 64
WIN_ROWS = 8
WIN_COLS = 16
COL_BLOCK = 16
KEY_SPAN = COL_BLOCK + WIN_COLS
N_COL_BLOCKS = GRID_W // COL_BLOCK
D_FF = int(math.ceil(8 * D_MODEL / 3 / 256) * 256)
ALPHA = (2 * DEPTH) ** 0.25
BETA = (8 * DEPTH) ** -0.25
LN_EPS = 1e-5
NEG_INF = -1e30

kernel_name = "fnet_natten_hybrid_encoder"


def _layer_norm(x, g, b):
    xf = x.astype(jnp.float32)
    mu = jnp.mean(xf, axis=-1, keepdims=True)
    var = jnp.mean(jnp.square(xf - mu), axis=-1, keepdims=True)
    y = (xf - mu) * lax.rsqrt(var + LN_EPS)
    return (y * g.astype(jnp.float32) + b.astype(jnp.float32)).astype(x.dtype)


def _fourier_mix(u):
    B, S, _ = u.shape
    ug = u.reshape(B, S, N_FGROUPS, FGROUP).astype(jnp.float32)
    f = jnp.fft.fft2(ug, axes=(1, 3), norm="ortho").real
    return f.reshape(B, S, FOURIER_WIDTH).astype(u.dtype)


def _neighbourhood_attention(q, k, v, rpb):
    B, S, _ = q.shape
    rows = S // GRID_W
    kh = min(WIN_ROWS, rows)
    grid = (B, rows, GRID_W, N_HEADS, HEAD_DIM)
    q = q.reshape(grid)
    k = k.reshape(grid)
    v = v.reshape(grid)
    r = np.arange(rows)
    rs = np.clip(r - kh // 2, 0, rows - kh)
    row_idx = rs[:, None] + np.arange(kh)[None, :]
    dr_idx = row_idx - r[:, None] + (WIN_ROWS - 1)
    k_rows = jnp.take(k, row_idx, axis=1)
    v_rows = jnp.take(v, row_idx, axis=1)
    scale = HEAD_DIM ** -0.5
    outs = []
    for j in range(N_COL_BLOCKS):
        c0 = j * COL_BLOCK
        ks = int(np.clip(c0 - WIN_COLS // 2, 0, GRID_W - KEY_SPAN))
        cq = c0 + np.arange(COL_BLOCK)
        cs = np.clip(cq - WIN_COLS // 2, 0, GRID_W - WIN_COLS)
        kc = ks + np.arange(KEY_SPAN)
        mask = (kc[None, :] >= cs[:, None]) & (kc[None, :] < cs[:, None] + WIN_COLS)
        dc_idx = np.clip(kc[None, :] - cq[:, None] + (WIN_COLS - 1), 0, 2 * WIN_COLS - 2)
        bias = rpb[:, dr_idx[:, None, :, None], dc_idx[None, :, None, :]]
        bias = jnp.transpose(bias, (1, 0, 2, 3, 4)).astype(jnp.float32)
        qb = q[:, :, c0:c0 + COL_BLOCK]
        kb = k_rows[:, :, :, ks:ks + KEY_SPAN]
        vb = v_rows[:, :, :, ks:ks + KEY_SPAN]
        s = jnp.einsum('brqhd,brawhd->brhqaw', qb, kb).astype(jnp.float32) * scale + bias[None]
        s = jnp.where(jnp.asarray(mask)[:, None, :], s, NEG_INF)
        p = jax.nn.softmax(s.reshape(B, rows, N_HEADS, COL_BLOCK, kh * KEY_SPAN), axis=-1)
        p = p.reshape(s.shape).astype(v.dtype)
        outs.append(jnp.einsum('brhqaw,brawhd->brqhd', p, vb))
    out = jnp.concatenate(outs, axis=2)
    return out.reshape(B, S, ATT_WIDTH)


def _layer(x, w_in, w_out, rpb, ln1_g, ln1_b, w_gate, w_up, w_down, ln2_g, ln2_b):
    h = jnp.einsum('bsd,de->bse', x, w_in)
    u_f = h[..., :FOURIER_WIDTH]
    q = h[..., FOURIER_WIDTH:FOURIER_WIDTH + ATT_WIDTH]
    k = h[..., FOURIER_WIDTH + ATT_WIDTH:FOURIER_WIDTH + 2 * ATT_WIDTH]
    v = h[..., FOURIER_WIDTH + 2 * ATT_WIDTH:]
    y = jnp.concatenate([_fourier_mix(u_f), _neighbourhood_attention(q, k, v, rpb)], axis=-1)
    mix = jnp.einsum('bse,ed->bsd', y, w_out)
    x = _layer_norm(ALPHA * x + mix, ln1_g, ln1_b)
    hid = jax.nn.silu(jnp.einsum('bsd,df->bsf', x, w_gate)) * jnp.einsum('bsd,df->bsf', x, w_up)
    ffn = jnp.einsum('bsf,fd->bsd', hid, w_down)
    return _layer_norm(ALPHA * x + ffn, ln2_g, ln2_b)


def setup_inputs(seed: int = 0) -> dict:
    key = jax.random.key(seed)
    ks = jax.random.split(key, 14)
    f32 = jnp.float32
    x_prompt = jax.random.normal(ks[0], (BATCH, SEQ, D_MODEL), f32)
    x_sample = jax.random.normal(ks[1], (DEC_BATCH, DEC_SEQ, D_MODEL), f32)
    w_in = jax.random.normal(ks[2], (DEPTH, D_MODEL, IN_WIDTH), f32) * D_MODEL ** -0.5
    col_scale = jnp.concatenate([jnp.ones((IN_WIDTH - ATT_WIDTH,), f32), jnp.full((ATT_WIDTH,), BETA, f32)])
    w_in = w_in * col_scale
    w_out = jax.random.normal(ks[3], (DEPTH, MIX_WIDTH, D_MODEL), f32) * (MIX_WIDTH ** -0.5 * BETA)
    rpb = jax.random.normal(ks[4], (DEPTH, N_HEADS, 2 * WIN_ROWS - 1, 2 * WIN_COLS - 1), f32) * 0.1
    ln1_g = 1.0 + 0.01 * jax.random.normal(ks[5], (DEPTH, D_MODEL), f32)
    ln1_b = 0.01 * jax.random.normal(ks[6], (DEPTH, D_MODEL), f32)
    w_gate = jax.random.normal(ks[7], (DEPTH, D_MODEL, D_FF), f32) * D_MODEL ** -0.5
    w_up = jax.random.normal(ks[8], (DEPTH, D_MODEL, D_FF), f32) * (D_MODEL ** -0.5 * BETA)
    w_down = jax.random.normal(ks[9], (DEPTH, D_FF, D_MODEL), f32) * (D_FF ** -0.5 * BETA)
    ln2_g = 1.0 + 0.01 * jax.random.normal(ks[10], (DEPTH, D_MODEL), f32)
    ln2_b = 0.01 * jax.random.normal(ks[11], (DEPTH, D_MODEL), f32)
    return {"x_prompt": x_prompt, "x_sample": x_sample, "w_in": w_in, "w_out": w_out,
            "rpb": rpb, "ln1_g": ln1_g, "ln1_b": ln1_b, "w_gate": w_gate, "w_up": w_up,
            "w_down": w_down, "ln2_g": ln2_g, "ln2_b": ln2_b}


def reference(x_prompt, x_sample, w_in, w_out, rpb, ln1_g, ln1_b, w_gate, w_up, w_down, ln2_g, ln2_b):
    y_prompt = x_prompt
    y_sample = x_sample
    for l in range(DEPTH):
        params = (w_in[l], w_out[l], rpb[l], ln1_g[l], ln1_b[l], w_gate[l], w_up[l], w_down[l], ln2_g[l], ln2_b[l])
        y_prompt = _layer(y_prompt, *params)
        y_sample = _layer(y_sample, *params)
    return (y_prompt, y_sample)
```

```cpp
#include <hip/hip_runtime.h>
#include <cstdio>
#include <cstdint>
#define MK_ONE_LAUNCH 1
namespace pg8 {
#define PG8_LAS __attribute__((address_space(3)))
typedef unsigned short bf16_t;
typedef short bf16x8 __attribute__((ext_vector_type(8)));
typedef float f32x4 __attribute__((ext_vector_type(4)));
typedef unsigned u32x4 __attribute__((ext_vector_type(4)));
constexpr int BM = 256, BK = 64, HALF = 128, HTB = HALF * BK * 2  , STAGE_BYTES = 8 * HTB, NXCD = 8, WGM = 8;

__host__ __device__ __forceinline__ int lds_byte(int r, int c) { const int st = (r >> 4) * 2 + (c >> 5), rr = r & 15, cc = c & 31, ob = rr * 64 + cc * 2; return st * 1024 + (ob ^ (((ob >> 9) & 1) << 5)); }
__host__ __device__ __forceinline__ void stage_rc(int b, int& R, int& C) { const int st = b / 1024, sb = b % 1024, swz = sb ^ (((sb >> 9) & 1) << 5); R = (st >> 1) * 16 + swz / 64; C = (st & 1) * 32 + (swz % 64) / 2; }
__host__ __device__ __forceinline__ int perm32(int rho) { const int n = rho >> 4, i = rho & 15; return 8 * (i >> 2) + 4 * n + (i & 3); }

struct Unit { int pm, pn; };
struct Gemm { const bf16_t* A; const bf16_t* Bt; int M, N, K, lda; };

struct StaticOrder {
    int nM, nN, nwg, G, c;
    __host__ __device__ void init(int M, int N, int G_, int c_) { nM = M / BM; nN = N / BM; nwg = nM * nN; G = G_; c = c_; }
    __host__ __device__ bool next(int i, Unit& u) const {
        const long L = (long)i * G + c; if (L >= nwg) return false;
        int wgid = (int)L; { const int q = nwg / NXCD, r = nwg % NXCD, xcd = wgid % NXCD, off = wgid / NXCD; wgid = (xcd < r ? xcd * (q + 1) : r * (q + 1) + (xcd - r) * q) + off; }
        const int nig = WGM * nN, gid = wgid / nig, fm = gid * WGM, gsz = (nM - fm) < WGM ? (nM - fm) : WGM;
        u.pm = fm + ((wgid % nig) % gsz); u.pn = (wgid % nig) / gsz; return true;
    }
    __device__ __forceinline__ void a_ready(const Unit&) const {}
    __device__ __forceinline__ void done(const Unit&) const {}
};

__device__ __forceinline__ unsigned cvt_pk_bf16(float lo, float hi) { unsigned r; asm volatile("v_cvt_pk_bf16_f32 %0, %1, %2" : "=v"(r) : "v"(lo), "v"(hi)); return r; }
typedef float f32x2 __attribute__((ext_vector_type(2)));
__device__ __forceinline__ f32x2 gelu_pk(f32x2 v) {
    const f32x2 av = __builtin_elementwise_abs(v), d = av * 0.2316418882f + 1.0f;
    f32x2 t; t.x = __builtin_amdgcn_rcpf(d.x); t.y = __builtin_amdgcn_rcpf(d.y);
    f32x2 q = t * 0.5307027145f + (-0.7265760135f); q = q * t + 0.7107068705f; q = q * t + (-0.142248368f); q = q * t + 0.127414796f; q = q * t;
    const f32x2 s = (v * v) * (-0.72134752044f);
    f32x2 e; e.x = __builtin_amdgcn_exp2f(s.x); e.y = __builtin_amdgcn_exp2f(s.y);
    const f32x2 m = v * (q * e), r = v - m;
    f32x2 o; o.x = v.x < 0.f ? m.x : r.x; o.y = v.y < 0.f ? m.y : r.y; return o;
}

template <int ACT  > struct EpiBf16 {
    static constexpr bool PERM = true, AFTER_DRAIN = false; static_assert(ACT == 0 || ACT == 1, "EpiBf16: ACT is 0 (none) or 1 (gelu_pk)");
    bf16_t* O; int ldc; const float* bias; int split_cols; size_t split_stride; float scale0;
    __device__ __forceinline__ void operator()(const f32x4 (&acc)[2][2][4][2], const Unit& u, int wr, int wc, int fr, int fq) const {
        const int row0 = u.pm * BM + wr * 64 + fr; int colt = u.pn * BM; bf16_t* base = O;
        float sc = 1.f; if (split_cols) { const int t = colt / split_cols; base += (size_t)t * split_stride; colt -= t * split_cols; if (t == 0) sc = scale0; }
        const int col0 = colt + wc * 32 + 8 * fq, bcol0 = u.pn * BM + wc * 32 + 8 * fq;
        f32x4 bv[2][2];
#pragma unroll
        for (int bj = 0; bj < 2; ++bj)
#pragma unroll
            for (int n = 0; n < 2; ++n) bv[bj][n] = bias ? *(const f32x4*)(bias + bcol0 + bj * HALF + 4 * n) : (f32x4){0.f, 0.f, 0.f, 0.f};
#pragma unroll
        for (int ai = 0; ai < 2; ++ai)
#pragma unroll
            for (int m = 0; m < 4; ++m) { bf16_t* rowp = base + (size_t)(row0 + ai * HALF + m * 16) * ldc + col0;
#pragma unroll
                for (int bj = 0; bj < 2; ++bj) { f32x4 v0 = acc[ai][bj][m][0] + bv[bj][0], v1 = acc[ai][bj][m][1] + bv[bj][1];
                    if (ACT == 1) { f32x2 a = gelu_pk((f32x2){v0[0], v0[1]}), b = gelu_pk((f32x2){v0[2], v0[3]}), c = gelu_pk((f32x2){v1[0], v1[1]}), d = gelu_pk((f32x2){v1[2], v1[3]});
                        v0 = (f32x4){a.x, a.y, b.x, b.y}; v1 = (f32x4){c.x, c.y, d.x, d.y}; }
                    v0 = v0 * sc; v1 = v1 * sc; u32x4 w; w.x = cvt_pk_bf16(v0[0], v0[1]); w.y = cvt_pk_bf16(v0[2], v0[3]); w.z = cvt_pk_bf16(v1[0], v1[1]); w.w = cvt_pk_bf16(v1[2], v1[3]);
                    *(u32x4*)(rowp + bj * HALF) = w; } }
    }
};

struct PanelStats {
    unsigned* xbuf;
    unsigned* cnt;
    unsigned* tmo;
    int ntn; float eps;
    unsigned code;
    __device__ __forceinline__ bool run(const f32x4 (&v)[2][2][4][2], const Unit& u, int wr, int wc, int fr, int fq, PG8_LAS unsigned char* lds, int wid, int lane) const {
        typedef float f32x2v __attribute__((ext_vector_type(2)));
        PG8_LAS f32x2v* P = (PG8_LAS f32x2v*)lds;
        PG8_LAS f32x2v* S = (PG8_LAS f32x2v*)(lds + 8192);
        PG8_LAS unsigned* flag = (PG8_LAS unsigned*)(lds + 8192 + 2048);
#pragma unroll
        for (int ai = 0; ai < 2; ++ai)
#pragma unroll
            for (int m = 0; m < 4; ++m) {
                float s = 0.f;
#pragma unroll
                for (int bj = 0; bj < 2; ++bj)
#pragma unroll
                    for (int n = 0; n < 2; ++n) { const f32x4 x = v[ai][bj][m][n]; s += (x[0] + x[1]) + (x[2] + x[3]); }
                s += __shfl_xor(s, 16); s += __shfl_xor(s, 32);
                const float mw = s * (1.0f / 64.0f); float q = 0.f;
#pragma unroll
                for (int bj = 0; bj < 2; ++bj)
#pragma unroll
                    for (int n = 0; n < 2; ++n) { const f32x4 d = v[ai][bj][m][n] - mw; q += (d[0] * d[0] + d[1] * d[1]) + (d[2] * d[2] + d[3] * d[3]); }
                q += __shfl_xor(q, 16); q += __shfl_xor(q, 32);
                if (fq == 0) P[(ai * HALF + wr * 64 + m * 16 + fr) * 4 + wc] = (f32x2v){mw, q};
            }
        asm volatile("s_waitcnt lgkmcnt(0)" ::: "memory"); __builtin_amdgcn_s_barrier(); asm volatile("" ::: "memory");
#if defined(BROKEN_EXCHANGE_NO_WAIT)
#warning BROKEN CONTROL BUILD: the row-statistics exchange does not wait; results are wrong by design
        if (blockIdx.x >= 64) { const long long t0_ = clock64(); while (clock64() - t0_ < 60000) __builtin_amdgcn_s_sleep(8); }
#endif
        const int row = wid * 32 + (lane & 31);
        if (lane < 32) {
            const f32x2v a = P[row * 4 + 0], b = P[row * 4 + 1], c = P[row * 4 + 2], d = P[row * 4 + 3];
            const float mt = (a.x + b.x + c.x + d.x) * 0.25f;
            const float da = a.x - mt, db = b.x - mt, dc = c.x - mt, dd = d.x - mt;
            const float m2 = (a.y + b.y) + (c.y + d.y) + 64.0f * ((da * da + db * db) + (dc * dc + dd * dd));
            unsigned long long* slot = (unsigned long long*)xbuf + ((size_t)(u.pm * BM + row) * 4 + u.pn);
            __hip_atomic_store(slot, ((unsigned long long)__float_as_uint(m2) << 32) | __float_as_uint(mt), __ATOMIC_RELAXED, __HIP_MEMORY_SCOPE_AGENT);
        }
        asm volatile("s_waitcnt vmcnt(0)" ::: "memory");
        if (lane == 0) __hip_atomic_fetch_add(cnt + 64 * u.pm, 1u, __ATOMIC_RELAXED, __HIP_MEMORY_SCOPE_AGENT);
        if (wid == 0) {
            bool dead = false; const unsigned long long t0 = __builtin_amdgcn_s_memrealtime(); const unsigned want = 8u * (unsigned)ntn;
            for (;;) {
#if defined(BROKEN_EXCHANGE_NO_WAIT)
                break;
#endif
                if ((unsigned)__builtin_amdgcn_readfirstlane(__hip_atomic_load(cnt + 64 * u.pm, __ATOMIC_RELAXED, __HIP_MEMORY_SCOPE_AGENT)) >= want) break;
                if (__builtin_amdgcn_s_memrealtime() - t0 > 2000000ull) {
                    if (lane == 0) { unsigned expect = 0u; __hip_atomic_compare_exchange_strong(tmo + 1, &expect, code | (unsigned)(u.pm & 0xff), __ATOMIC_RELAXED, __ATOMIC_RELAXED, __HIP_MEMORY_SCOPE_AGENT);
                                     __hip_atomic_store(tmo, 1u, __ATOMIC_RELAXED, __HIP_MEMORY_SCOPE_AGENT); }
                    dead = true; break; }
                __builtin_amdgcn_s_sleep(2);
            }
            __builtin_amdgcn_fence(__ATOMIC_ACQUIRE, "agent");
            if (lane == 0) flag[0] = dead ? 1u : 0u;
        }
        asm volatile("s_waitcnt vmcnt(0) lgkmcnt(0)" ::: "memory"); __builtin_amdgcn_s_barrier(); asm volatile("" ::: "memory");
        const bool bad = flag[0] != 0u;
        if (lane < 32) {
            const unsigned long long* slot = (const unsigned long long*)xbuf + (size_t)(u.pm * BM + row) * 4; float mt[4], m2[4]; float ms = 0.f;
#pragma unroll
            for (int t = 0; t < 4; ++t) { if (t < ntn) { const unsigned long long w = __hip_atomic_load(slot + t, __ATOMIC_RELAXED, __HIP_MEMORY_SCOPE_AGENT); mt[t] = __uint_as_float((unsigned)w); m2[t] = __uint_as_float((unsigned)(w >> 32)); } else { mt[t] = 0.f; m2[t] = 0.f; } ms += mt[t]; }
            const float mean = ms / (float)ntn; float q = 0.f;
#pragma unroll
            for (int t = 0; t < 4; ++t) if (t < ntn) { const float dm = mt[t] - mean; q += m2[t] + 256.0f * dm * dm; }
            S[row] = (f32x2v){mean, 1.0f / sqrtf(q / (256.0f * (float)ntn) + eps)};
        }
        asm volatile("s_waitcnt lgkmcnt(0)" ::: "memory"); __builtin_amdgcn_s_barrier(); asm volatile("" ::: "memory");
        return bad;
    }
};
struct EpiLnRes {
    static constexpr bool PERM = false, AFTER_DRAIN = true;
    const float* base; float* out; int ldc; const float* bias; PanelStats st; unsigned poison;
    __device__ __forceinline__ void fused(f32x4 (&acc)[2][2][4][2], const Unit& u, int wr, int wc, int fr, int fq, PG8_LAS unsigned char* lds, int wid, int lane) const {
        typedef float f32x2v __attribute__((ext_vector_type(2)));
        const PG8_LAS f32x2v* S = (const PG8_LAS f32x2v*)(lds + 8192);
        const int col0 = u.pn * BM + wc * 32 + 4 * fq;
#pragma unroll
        for (int bj = 0; bj < 2; ++bj)
#pragma unroll
            for (int n = 0; n < 2; ++n) { const f32x4 bv = bias ? *(const f32x4*)(bias + col0 + bj * HALF + n * 16) : (f32x4){0.f, 0.f, 0.f, 0.f};
#pragma unroll
                for (int ai = 0; ai < 2; ++ai)
#pragma unroll
                    for (int m = 0; m < 4; ++m) acc[ai][bj][m][n] += bv; }
        f32x4 pre[4][2][2];
#pragma unroll
        for (int m = 0; m < 4; ++m) { const size_t off = (size_t)(u.pm * BM + wr * 64 + m * 16 + fr) * ldc + col0;
#pragma unroll
            for (int bj = 0; bj < 2; ++bj)
#pragma unroll
                for (int n = 0; n < 2; ++n) pre[m][bj][n] = *(const f32x4*)(base + off + bj * HALF + n * 16); }
        const bool bad = st.run(acc, u, wr, wc, fr, fq, lds, wid, lane) || poison != 0u;
        const float qnan = __builtin_nanf("");
#pragma unroll
        for (int ai = 0; ai < 2; ++ai)
#pragma unroll
            for (int m = 0; m < 4; ++m) { const int r = ai * HALF + wr * 64 + m * 16 + fr; const f32x2v sr = S[r]; const size_t off = (size_t)(u.pm * BM + r) * ldc + col0;
#pragma unroll
                for (int bj = 0; bj < 2; ++bj)
#pragma unroll
                    for (int n = 0; n < 2; ++n) { const f32x4 bs = ai == 0 ? pre[m][bj][n] : *(const f32x4*)(base + off + bj * HALF + n * 16); f32x4 o = bs + (acc[ai][bj][m][n] - sr.x) * sr.y;
                        if (bad) o = (f32x4){qnan, qnan, qnan, qnan}; *(f32x4*)(out + off + bj * HALF + n * 16) = o; }
                if (m & 1) asm volatile("" ::: "memory"); }
    }
};
struct EpiLnResLn {
    static constexpr bool PERM = false, AFTER_DRAIN = true;
    const float* base; float* out; bf16_t* xn; int ldc; const float* bias; PanelStats st1, st2; unsigned poison;
    __device__ __forceinline__ void fused(f32x4 (&acc)[2][2][4][2], const Unit& u, int wr, int wc, int fr, int fq, PG8_LAS unsigned char* lds, int wid, int lane) const {
        typedef float f32x2v __attribute__((ext_vector_type(2))); typedef unsigned u32x2v __attribute__((ext_vector_type(2)));
        const PG8_LAS f32x2v* S = (const PG8_LAS f32x2v*)(lds + 8192);
        const int col0 = u.pn * BM + wc * 32 + 4 * fq;
#pragma unroll
        for (int bj = 0; bj < 2; ++bj)
#pragma unroll
            for (int n = 0; n < 2; ++n) { const f32x4 bv = bias ? *(const f32x4*)(bias + col0 + bj * HALF + n * 16) : (f32x4){0.f, 0.f, 0.f, 0.f};
#pragma unroll
                for (int ai = 0; ai < 2; ++ai)
#pragma unroll
                    for (int m = 0; m < 4; ++m) acc[ai][bj][m][n] += bv; }
        bool bad = st1.run(acc, u, wr, wc, fr, fq, lds, wid, lane) || poison != 0u;
        const float qnan = __builtin_nanf("");
#pragma unroll
        for (int ai = 0; ai < 2; ++ai)
#pragma unroll
            for (int m = 0; m < 4; ++m) { const int r = ai * HALF + wr * 64 + m * 16 + fr; const f32x2v sr = S[r]; const size_t off = (size_t)(u.pm * BM + r) * ldc + col0;
#pragma unroll
                for (int bj = 0; bj < 2; ++bj)
#pragma unroll
                    for (int n = 0; n < 2; ++n) { const f32x4 bs = *(const f32x4*)(base + off + bj * HALF + n * 16); acc[ai][bj][m][n] = bs + (acc[ai][bj][m][n] - sr.x) * sr.y; }
                asm volatile("" : "+v"(acc[ai][0][m][0]), "+v"(acc[ai][0][m][1]), "+v"(acc[ai][1][m][0]), "+v"(acc[ai][1][m][1]));
                if (m & 1) asm volatile("" ::: "memory"); }
        const bool bad1 = bad;
        bad = st2.run(acc, u, wr, wc, fr, fq, lds, wid, lane) || bad;
#pragma unroll
        for (int ai = 0; ai < 2; ++ai)
#pragma unroll
            for (int m = 0; m < 4; ++m) { const int r = ai * HALF + wr * 64 + m * 16 + fr; const f32x2v sr = S[r]; const size_t off = (size_t)(u.pm * BM + r) * ldc + col0;
#pragma unroll
                for (int bj = 0; bj < 2; ++bj)
#pragma unroll
                    for (int n = 0; n < 2; ++n) { const f32x4 x1 = acc[ai][bj][m][n]; *(f32x4*)(out + off + bj * HALF + n * 16) = bad1 ? (f32x4){qnan, qnan, qnan, qnan} : x1;
                        const f32x4 o = (x1 - sr.x) * sr.y; u32x2v w; w.x = cvt_pk_bf16(o[0], o[1]); w.y = cvt_pk_bf16(o[2], o[3]);
                        if (bad) { w.x = 0x7fc07fc0u; w.y = 0x7fc07fc0u; } *(u32x2v*)(xn + off + bj * HALF + n * 16) = w; }
                asm volatile("" ::: "memory"); }
    }
};

template <class Epi, class Sched, bool ALIGN_EPI = false, bool SP2 = false>
__device__ __forceinline__ void gemm_phase(PG8_LAS unsigned char* lds, const Gemm g, const Sched& S, const Epi& E) {
    const int tid = threadIdx.x, wid = __builtin_amdgcn_readfirstlane(tid >> 6), lane = tid & 63, wr = wid >> 2, wc = wid & 3, fr = lane & 15, fq = lane >> 4;
    const int K = g.K, nt = K / BK;
    unsigned voffA[2], voffB[2];
#pragma unroll
    for (int i = 0; i < 2; ++i) { int R, C; stage_rc(tid * 16 + i * 8192, R, C); const int Rb = Epi::PERM ? ((R & ~31) + perm32(R & 31)) : R;
        voffA[i] = (unsigned)(R * g.lda + C) * 2u; voffB[i] = (unsigned)(Rb * K + C) * 2u; }
    const size_t kstep = (size_t)(BK * 2);
    const size_t hstepB = (size_t)HALF * K * 2, hstepA = (size_t)HALF * g.lda * 2;
    const size_t tstepA = 2 * hstepA, tstepB = 2 * hstepB;
    const unsigned ldsw = (unsigned)wid * 1024u;
    const int aoff = lds_byte(wr * 64 + fr, fq * 8), boff = lds_byte(wc * 32 + fr, fq * 8);
#define PG8_SA(b, h) (((b) * 2 + (h)) * HTB)
#define PG8_SB(b, h) ((4 + (b) * 2 + (h)) * HTB)
#define PG8_STAGE(bufoff, gbase, voff) do { _Pragma("unroll") for (int _i = 0; _i < 2; ++_i) \
        __builtin_amdgcn_global_load_lds((const unsigned*)((const char*)(gbase) + (voff)[_i]), (PG8_LAS unsigned*)(lds + (bufoff) + ldsw + _i * 8192), 16, 0, 0); } while (0)
#define PG8_LDA(dst, b, h) do { _Pragma("unroll") for (int m = 0; m < 4; ++m) _Pragma("unroll") for (int k = 0; k < 2; ++k) dst[m][k] = *(const PG8_LAS bf16x8*)(lds + PG8_SA(b, h) + aoff + m * 2048 + k * 1024); } while (0)
#define PG8_LDB(dst, b, h) do { _Pragma("unroll") for (int n = 0; n < 2; ++n) _Pragma("unroll") for (int k = 0; k < 2; ++k) dst[n][k] = *(const PG8_LAS bf16x8*)(lds + PG8_SB(b, h) + boff + n * 2048 + k * 1024); } while (0)
#define PG8_MMA(ai, bj, At, Bt) do { __builtin_amdgcn_s_setprio(1); _Pragma("unroll") for (int m = 0; m < 4; ++m) _Pragma("unroll") for (int n = 0; n < 2; ++n) _Pragma("unroll") for (int k = 0; k < 2; ++k) \
        acc[ai][bj][m][n] = __builtin_amdgcn_mfma_f32_16x16x32_bf16(Bt[n][k], At[m][k], acc[ai][bj][m][n], 0, 0, 0); __builtin_amdgcn_s_setprio(0); } while (0)
#define PG8_WAIT_V(n) asm volatile("s_waitcnt vmcnt(" #n ")" ::: "memory")
#define PG8_WAIT_L(n) asm volatile("s_waitcnt lgkmcnt(" #n ")" ::: "memory")
#define PG8_BAR __builtin_amdgcn_s_barrier()
#define PG8_SCHED __builtin_amdgcn_sched_barrier(0)
    Unit cur, nxt; int ui = 0;
    if (!S.next(0, cur)) return;
    f32x4 acc[2][2][4][2];
#pragma unroll
    for (int a = 0; a < 2; ++a)
#pragma unroll
        for (int b = 0; b < 2; ++b)
#pragma unroll
            for (int m = 0; m < 4; ++m)
#pragma unroll
                for (int n = 0; n < 2; ++n) acc[a][b][m][n] = (f32x4){0.f, 0.f, 0.f, 0.f};
    bf16x8 At[4][2], B0[2][2], B1[2][2];
    const char* cA = (const char*)g.A + (size_t)cur.pm * tstepA; const char* cB = (const char*)g.Bt + (size_t)cur.pn * tstepB;
    S.a_ready(cur);
    if constexpr (SP2) {
        PG8_STAGE(PG8_SB(0, 0), cB, voffB); PG8_STAGE(PG8_SB(0, 1), cB + hstepB, voffB); PG8_STAGE(PG8_SA(0, 0), cA, voffA); PG8_STAGE(PG8_SA(0, 1), cA + hstepA, voffA);
        if (wr == 1) PG8_BAR;
        PG8_WAIT_V(2); PG8_BAR;
        PG8_STAGE(PG8_SB(1, 0), cB + kstep, voffB); PG8_STAGE(PG8_SA(1, 0), cA + kstep, voffA); PG8_STAGE(PG8_SB(1, 1), cB + hstepB + kstep, voffB);
        PG8_WAIT_V(6); PG8_BAR;
    } else {
        PG8_STAGE(PG8_SB(0, 0), cB, voffB); PG8_STAGE(PG8_SA(0, 0), cA, voffA); PG8_STAGE(PG8_SB(0, 1), cB + hstepB, voffB); PG8_STAGE(PG8_SA(0, 1), cA + hstepA, voffA);
        if (wr == 1) PG8_BAR;
        PG8_WAIT_V(4); PG8_BAR;
        PG8_STAGE(PG8_SB(1, 0), cB + kstep, voffB); PG8_STAGE(PG8_SA(1, 0), cA + kstep, voffA); PG8_STAGE(PG8_SB(1, 1), cB + hstepB + kstep, voffB);
        PG8_WAIT_V(6); PG8_BAR;
    }
    for (;;) {
        const bool has_next = S.next(ui + 1, nxt);
        const char* nA = has_next ? (const char*)g.A + (size_t)nxt.pm * tstepA : cA; const char* nB = has_next ? (const char*)g.Bt + (size_t)nxt.pn * tstepB : cB;
        for (int t = 0; t < nt; t += 2) {
            const bool last = (t == nt - 2);
            const char* a1 = cA + (size_t)(t + 1) * kstep;
            const char* a2 = last ? nA : cA + (size_t)(t + 2) * kstep; const char* b2 = last ? nB : cB + (size_t)(t + 2) * kstep;
            const char* a3 = a2 + kstep; const char* b3 = b2 + kstep;
            if (last && has_next) S.a_ready(nxt);
            if constexpr (SP2) {
            PG8_LDB(B0, 0, 0); PG8_LDB(B1, 0, 1); PG8_SCHED; PG8_LDA(At, 0, 0); PG8_STAGE(PG8_SA(1, 1), a1 + hstepA, voffA);
            PG8_WAIT_V(8); PG8_WAIT_L(0); PG8_BAR; PG8_MMA(0, 0, At, B0); PG8_MMA(0, 1, At, B1); PG8_BAR; PG8_SCHED;
            PG8_LDA(At, 0, 1); PG8_STAGE(PG8_SB(0, 0), b2, voffB); PG8_STAGE(PG8_SB(0, 1), b2 + hstepB, voffB); PG8_STAGE(PG8_SA(0, 0), a2, voffA);
            PG8_WAIT_V(8); PG8_WAIT_L(0); PG8_BAR; PG8_MMA(1, 0, At, B0); PG8_MMA(1, 1, At, B1); PG8_BAR; PG8_SCHED;
            PG8_LDB(B0, 1, 0); PG8_LDB(B1, 1, 1); PG8_SCHED; PG8_LDA(At, 1, 0); PG8_STAGE(PG8_SA(0, 1), a2 + hstepA, voffA);
            PG8_WAIT_V(8); PG8_WAIT_L(0); PG8_BAR; PG8_MMA(0, 0, At, B0); PG8_MMA(0, 1, At, B1); PG8_BAR; PG8_SCHED;
            PG8_LDA(At, 1, 1); PG8_STAGE(PG8_SB(1, 0), b3, voffB); PG8_STAGE(PG8_SB(1, 1), b3 + hstepB, voffB); PG8_STAGE(PG8_SA(1, 0), a3, voffA);
            PG8_WAIT_V(8); PG8_WAIT_L(0); PG8_BAR; PG8_MMA(1, 0, At, B0); PG8_MMA(1, 1, At, B1); PG8_BAR; PG8_SCHED;
            } else {
            PG8_LDB(B0, 0, 0); PG8_SCHED; PG8_LDA(At, 0, 0); PG8_STAGE(PG8_SA(1, 1), a1 + hstepA, voffA);
            PG8_WAIT_L(8); PG8_BAR; PG8_WAIT_L(0); PG8_MMA(0, 0, At, B0); PG8_BAR; PG8_SCHED;
            PG8_LDB(B1, 0, 1); PG8_STAGE(PG8_SB(0, 0), b2, voffB);
            PG8_BAR; PG8_WAIT_L(0); PG8_MMA(0, 1, At, B1); PG8_BAR;
            PG8_LDA(At, 0, 1); PG8_STAGE(PG8_SA(0, 0), a2, voffA);
            PG8_BAR; PG8_WAIT_L(0); PG8_MMA(1, 0, At, B0); PG8_BAR; PG8_SCHED;
            PG8_STAGE(PG8_SB(0, 1), b2 + hstepB, voffB);
            PG8_WAIT_V(6); PG8_BAR; PG8_MMA(1, 1, At, B1); PG8_BAR;
            PG8_LDB(B0, 1, 0); PG8_SCHED; PG8_LDA(At, 1, 0); PG8_STAGE(PG8_SA(0, 1), a2 + hstepA, voffA);
            PG8_WAIT_L(8); PG8_BAR; PG8_WAIT_L(0); PG8_MMA(0, 0, At, B0); PG8_BAR; PG8_SCHED;
            PG8_LDB(B1, 1, 1); PG8_STAGE(PG8_SB(1, 0), b3, voffB);
            PG8_BAR; PG8_WAIT_L(0); PG8_MMA(0, 1, At, B1); PG8_BAR;
            PG8_LDA(At, 1, 1); PG8_STAGE(PG8_SA(1, 0), a3, voffA);
            PG8_BAR; PG8_WAIT_L(0); PG8_MMA(1, 0, At, B0); PG8_BAR; PG8_SCHED;
            PG8_STAGE(PG8_SB(1, 1), b3 + hstepB, voffB);
            PG8_WAIT_V(6); PG8_BAR; PG8_MMA(1, 1, At, B1); PG8_BAR;
            }
        }
        if constexpr (ALIGN_EPI) { if (wr == 0) PG8_BAR; }
        if constexpr (!Epi::AFTER_DRAIN) { E(acc, cur, wr, wc, fr, fq); S.done(cur); }
        if (!has_next) break;
#pragma unroll
        for (int a = 0; a < 2; ++a)
#pragma unroll
            for (int b = 0; b < 2; ++b)
#pragma unroll
                for (int m = 0; m < 4; ++m)
#pragma unroll
                    for (int n = 0; n < 2; ++n) acc[a][b][m][n] = (f32x4){0.f, 0.f, 0.f, 0.f};
        cur = nxt; cA = nA; cB = nB; ++ui;
        if constexpr (ALIGN_EPI) { if (wr == 1) PG8_BAR; }
    }
    PG8_WAIT_V(0);
    if constexpr (!ALIGN_EPI) { if (wr == 0) PG8_BAR; }
    PG8_BAR;
    if constexpr (Epi::AFTER_DRAIN) { E.fused(acc, cur, wr, wc, fr, fq, lds, wid, lane); S.done(cur); }
#undef PG8_SA
#undef PG8_SB
#undef PG8_STAGE
#undef PG8_LDA
#undef PG8_LDB
#undef PG8_MMA
#undef PG8_WAIT_V
#undef PG8_WAIT_L
#undef PG8_BAR
#undef PG8_SCHED
}
}
namespace pg8 {
struct EpiSwiGLU {
    static constexpr bool PERM = true, AFTER_DRAIN = false;
    bf16_t* O; int ldc;
    __device__ __forceinline__ void operator()(const f32x4 (&acc)[2][2][4][2], const Unit& u, int wr, int wc, int fr, int fq) const {
        const int row0 = u.pm * BM + wr * 64 + fr, col0 = u.pn * HALF + wc * 32 + 8 * fq;
#pragma unroll
        for (int ai = 0; ai < 2; ++ai)
#pragma unroll
            for (int m = 0; m < 4; ++m) { bf16_t* rowp = O + (size_t)(row0 + ai * HALF + m * 16) * ldc + col0;
                float h[8];
#pragma unroll
                for (int n = 0; n < 2; ++n)
#pragma unroll
                    for (int i = 0; i < 4; ++i) { const float g = acc[ai][0][m][n][i], up = acc[ai][1][m][n][i];
                        const float e = __builtin_amdgcn_exp2f(g * -1.4426950408889634f);
                        h[4 * n + i] = g * __builtin_amdgcn_rcpf(1.0f + e) * up; }
                u32x4 w; w.x = cvt_pk_bf16(h[0], h[1]); w.y = cvt_pk_bf16(h[2], h[3]); w.z = cvt_pk_bf16(h[4], h[5]); w.w = cvt_pk_bf16(h[6], h[7]);
                *(u32x4*)rowp = w; }
    }
};
}
#ifndef PG8_SP2
#define PG8_SP2 true
#endif
#ifndef PG8_ALIGN
#define PG8_ALIGN true
#endif
constexpr int DM = 1024, M = 32768, DEPTH = 2, INW = 2048, DFF = 2816, NH = 8;
constexpr float ALPHA = 1.4142135623730951f;
constexpr float LN_EPS = 1e-5f;
constexpr float LOG2E = 1.4426950408889634f;
constexpr float QSCALE = 0.125f * LOG2E;
__device__ __forceinline__ void seq_info(int sq, int& base, int& S, int& N1) { base = sq == 0 ? 0 : (sq == 1 ? 8192 : 16384); S = sq == 2 ? 16384 : 8192; N1 = S >> 7; }
constexpr size_t MiB = 1u << 20;
constexpr size_t WS_XB = 0;
constexpr size_t WS_H = 64 * MiB;
constexpr size_t WS_YP = 192 * MiB;
constexpr size_t WS_WIN = 224 * MiB;
constexpr size_t WS_WOUT = 228 * MiB;
constexpr size_t WS_HID = 64 * MiB;
constexpr size_t WS_WGU = 240 * MiB;
constexpr size_t WS_WDN = 240 * MiB;
constexpr size_t WS_CTL = 251 * MiB, CTL_ZERO_BYTES = 1 * MiB;
constexpr size_t WS_XCH = 252 * MiB;
constexpr size_t WS_END = 256 * MiB;
static_assert(WS_HID + (size_t)M * DFF * 2 <= WS_WGU && WS_WGU + (size_t)2 * DFF * DM * 2 <= WS_CTL && WS_WOUT + (size_t)DM * DM * 2 <= WS_HID + (size_t)M * DFF * 2, "ws map");
constexpr int CW_TMO = 0, CW_CODE = 1, CW_BAR = 4096;
constexpr int RING_OFF = 0, RING_BYTES = 131072;
constexpr int LDSCTL_OFF = RING_BYTES, MISC_OFF = LDSCTL_OFF + 320;
constexpr int LDS_BYTES = 147456;
constexpr int NWAVES = 8;
#define GAS __attribute__((address_space(1)))
#define LAS __attribute__((address_space(3)))
typedef unsigned short bf16;
typedef unsigned v4u __attribute__((ext_vector_type(4)));
typedef float f32x4 __attribute__((ext_vector_type(4)));
typedef short bf16x8 __attribute__((ext_vector_type(8)));
typedef GAS unsigned gu32;
typedef GAS unsigned long long gu64;
#define RLX_AGENT __ATOMIC_RELAXED, __HIP_MEMORY_SCOPE_AGENT
#define LDS_WAIT() asm volatile("s_waitcnt lgkmcnt(0)" ::: "memory")
#define VM_WAIT() asm volatile("s_waitcnt vmcnt(0)" ::: "memory")
__device__ __forceinline__ unsigned long long rt() { return __builtin_amdgcn_s_memrealtime(); }
__device__ __forceinline__ unsigned f2bf(float f) { unsigned u = __builtin_bit_cast(unsigned, f); return (u + 0x7fffu + ((u >> 16) & 1u)) >> 16; }
__device__ __forceinline__ unsigned pk2(float lo, float hi) { return f2bf(lo) | (f2bf(hi) << 16); }

#define XB_TMO      128
#define XB_XCNT(j)  (256  + 64 * (j))
#define XB_XSUB(j)  (1280 + 64 * (j))
#define XB_XGEN(j)  (2304 + 64 * (j))
#define XB_TOP      3328
#define XB_TOPGEN   3392
#define XCD_BAR_WORDS 3456
#define XB_SPIN_CAP (1u << 18)

__device__ __forceinline__ unsigned xb_ld(unsigned* p)              { return __hip_atomic_load(p, __ATOMIC_RELAXED, __HIP_MEMORY_SCOPE_AGENT); }
__device__ __forceinline__ unsigned xb_add(unsigned* p, unsigned v) { return __hip_atomic_fetch_add(p, v, __ATOMIC_RELAXED, __HIP_MEMORY_SCOPE_AGENT); }
__device__ __forceinline__ unsigned xb_xcc_id() { return (unsigned)__builtin_amdgcn_s_getreg((3 << 11) | 20) & 0xFu; }
#define XB_SPIN(cond, bar) do { unsigned _sp = 0; while (cond) { __builtin_amdgcn_s_sleep(1); \
    if ((++_sp & 255u) == 0u) { if (xb_ld(&(bar)[XB_TMO])) break; if (_sp > XB_SPIN_CAP) { atomicAdd(&(bar)[XB_TMO], 1u); break; } } } } while (0)

struct XcdBarrier {
    unsigned* bar; unsigned x;
    volatile LAS unsigned* st;
};

__device__ __forceinline__ XcdBarrier xcd_barrier_post(unsigned* bar, volatile LAS unsigned* st) {
    XcdBarrier b; b.bar = bar; b.x = xb_xcc_id(); b.st = st;
    if (threadIdx.x == 0) (void)xb_add(&bar[XB_XCNT(b.x)], 1u);
    return b;
}
__device__ __forceinline__ void xcd_barrier_complete(unsigned* bar, unsigned x, unsigned& nloc, unsigned& nx) {
    const unsigned G = gridDim.x * gridDim.y * gridDim.z;
    unsigned sum, cnt, mine, sp = 0u;
    for (;;) {
        sum = 0u; cnt = 0u; mine = 0u;
#pragma unroll
        for (unsigned j = 0; j < 16; ++j) { const unsigned c = xb_ld(&bar[XB_XCNT(j)]); sum += c; cnt += (c > 0u) ? 1u : 0u; mine = (j == x) ? c : mine; }
        if (sum == G) break;
        __builtin_amdgcn_s_sleep(1);
        if ((++sp & 255u) == 0u) { if (xb_ld(&bar[XB_TMO])) break; if (sp > XB_SPIN_CAP) { atomicAdd(&bar[XB_TMO], 1u); break; } }
    }
    nloc = mine > 0u ? mine : 1u; nx = cnt > 0u ? cnt : 1u;
}

__device__ __forceinline__ void xcd_barrier(const XcdBarrier& b) {
    asm volatile("s_waitcnt vmcnt(0)" ::: "memory");
    __syncthreads();
    if (threadIdx.x == 0) {
        unsigned* bar = b.bar;
        __builtin_amdgcn_s_waitcnt(0);
        unsigned nloc = b.st[0], nx = b.st[1];
        if (nloc == 0u) { xcd_barrier_complete(bar, b.x, nloc, nx); b.st[0] = nloc; b.st[1] = nx; }
        const unsigned old = xb_add(&bar[XB_XSUB(b.x)], 1u);
        const unsigned gen = old / nloc;
        if (old + 1u == (gen + 1u) * nloc) {
            __builtin_amdgcn_fence(__ATOMIC_RELEASE, "agent");
            asm volatile("s_waitcnt vmcnt(0)" ::: "memory");
            const unsigned og = xb_add(&bar[XB_TOP], 1u);
            const unsigned tg = og / nx;
            if (og + 1u == (tg + 1u) * nx) xb_add(&bar[XB_TOPGEN], 1u);
            else XB_SPIN(xb_ld(&bar[XB_TOPGEN]) == tg, bar);
            __builtin_amdgcn_fence(__ATOMIC_ACQUIRE, "agent");
            xb_add(&bar[XB_XGEN(b.x)], 1u);
            asm volatile("s_waitcnt vmcnt(0)" ::: "memory");
        } else {
            XB_SPIN(xb_ld(&bar[XB_XGEN(b.x)]) == gen, bar);
            __builtin_amdgcn_fence(__ATOMIC_ACQUIRE, "agent");
            asm volatile("s_waitcnt vmcnt(0)" ::: "memory");
        }
    }
    __syncthreads();
}

__device__ __forceinline__ float bf2f(unsigned b) { return __uint_as_float(b << 16); }
__device__ __forceinline__ float bflo(unsigned w) { return __uint_as_float(w << 16); }
__device__ __forceinline__ float bfhi(unsigned w) { return __uint_as_float(w & 0xffff0000u); }
__device__ __forceinline__ float wave_sum(float v) {
#pragma unroll
    for (int o = 1; o < 64; o <<= 1) v += __shfl_xor(v, o);
    return v;
}
struct Ctx { LAS unsigned char* lds; int tid, lane, wave, gw, NGW, gt, NGT; };

__device__ __forceinline__ void ph_convert_x(const Ctx& C, const float* xp, const float* xs, bf16* XN) {
    for (int m = C.gw; m < M; m += C.NGW) {
        const float* src = m < 16384 ? xp + (size_t)m * DM : xs + (size_t)(m - 16384) * DM;
        const GAS f32x4* xr = (const GAS f32x4*)src + C.lane;
        GAS unsigned long long* o8 = (GAS unsigned long long*)(XN + (size_t)m * DM) + C.lane;
#pragma unroll
        for (int j = 0; j < 4; ++j) { const f32x4 v = xr[64 * j]; o8[64 * j] = (unsigned long long)pk2(v.x, v.y) | ((unsigned long long)pk2(v.z, v.w) << 32); }
    }
}
__device__ __forceinline__ void tr_item(const float* W, int ldw, int k0, int n0, bf16* WT, int ldt, int drow0, float scale, LAS float* scr, int lane) {
#pragma unroll 8
    for (int i = 0; i < 32; ++i) { const int kk = 2 * i + (lane >> 5); scr[kk * 33 + (lane & 31)] = W[(size_t)(k0 + kk) * ldw + n0 + (lane & 31)]; }
    LDS_WAIT(); asm volatile("" ::: "memory");
    const int c = lane & 7;
#pragma unroll
    for (int j = 0; j < 4; ++j) { const int n = (lane >> 3) + 8 * j; const LAS float* s = scr + (8 * c) * 33 + n;
        v4u o; o.x = pk2(s[0 * 33] * scale, s[1 * 33] * scale); o.y = pk2(s[2 * 33] * scale, s[3 * 33] * scale); o.z = pk2(s[4 * 33] * scale, s[5 * 33] * scale); o.w = pk2(s[6 * 33] * scale, s[7 * 33] * scale);
        *(GAS v4u*)(WT + (size_t)(drow0 + n) * ldt + k0 + 8 * c) = o; }
    LDS_WAIT(); asm volatile("" ::: "memory");
}
constexpr int TAB_OFF = 126976;
__device__ __forceinline__ void build_tab(const Ctx& C, int n) {
    LAS float* ct = (LAS float*)(C.lds + TAB_OFF); LAS float* st = ct + 256;
    for (int j = C.tid; j < n; j += NWAVES * 64) { float s, c; sincospif(2.0f * (float)j / (float)n, &s, &c); ct[j] = c; st[j] = s; }
    __syncthreads();
}
__device__ __forceinline__ void ph_prep_w(const Ctx& C, const float* w_in, const float* w_out, const float* w_gate, const float* w_up, bf16* WIN, bf16* WOUT, bf16* WGU) {
    build_tab(C, 128);
    const LAS float* ct = (const LAS float*)(C.lds + TAB_OFF); const LAS float* st = ct + 256;
    LAS float* scr = (LAS float*)(C.lds + RING_OFF + C.wave * 16384);
    constexpr int I_QKV = 16 * 48, I_WO = 8 * 32, I_G = 16 * 88, I_E = 1024 * 4, I_F = (1024 * 512) / 64;
    constexpr int NIT = I_QKV + I_WO + 2 * I_G + I_E + I_F;
    for (int it = C.gw; it < NIT; it += C.NGW) {
        int r = it;
        if (r < I_QKV) { const int kb = r / 48, nb = r % 48, n0 = 512 + 32 * nb; tr_item(w_in, INW, 64 * kb, n0, WIN, DM, n0, n0 < 1024 ? QSCALE : 1.0f, scr, C.lane); continue; } r -= I_QKV;
        if (r < I_WO) { const int kb = r / 32, nb = r % 32; tr_item(w_out, DM, 512 + 64 * kb, 32 * nb, WOUT, DM, 32 * nb, 1.0f, scr, C.lane); continue; } r -= I_WO;
        if (r < I_G) { const int kb = r / 88, nb = r % 88, n0 = 32 * nb; tr_item(w_gate, DFF, 64 * kb, n0, WGU, DM, 256 * (n0 >> 7) + (n0 & 127), 1.0f, scr, C.lane); continue; } r -= I_G;
        if (r < I_G) { const int kb = r / 88, nb = r % 88, n0 = 32 * nb; tr_item(w_up, DFF, 64 * kb, n0, WGU, DM, 256 * (n0 >> 7) + 128 + (n0 & 127), 1.0f, scr, C.lane); continue; } r -= I_G;
        if (r < I_E) {
            const int k = r >> 2, gi = r & 3; const float* wr = w_in + (size_t)k * INW + gi * 128;
            float a0 = 0.f, a1 = 0.f;
            for (int c = 0; c < 128; ++c) { const float w = wr[c]; a0 += w * ct[(C.lane * c) & 127]; a1 += w * (C.lane == 0 ? ct[(64 * c) & 127] : st[(C.lane * c) & 127]); }
            const float sc = 0.08838834764831845f;
            WIN[(size_t)(gi * 128 + C.lane) * DM + k] = (bf16)f2bf(a0 * sc); WIN[(size_t)(gi * 128 + 64 + C.lane) * DM + k] = (bf16)f2bf(a1 * sc);
            continue; } r -= I_E;
        {
            const int t = r * 64 + C.lane, n = t >> 9, kk = t & 511, gi = kk >> 7, slot = kk & 127; const float* wb = w_out + (size_t)(gi * 128) * DM + n;
            float v;
            if (slot == 0) v = wb[0];
            else if (slot < 64) v = wb[(size_t)slot * DM] + wb[(size_t)(128 - slot) * DM];
            else if (slot == 64) v = wb[(size_t)64 * DM];
            else { const int m = slot - 64; v = wb[(size_t)(128 - m) * DM] - wb[(size_t)m * DM]; }
            WOUT[(size_t)n * DM + kk] = (bf16)f2bf(v);
        }
    }
}
__device__ __forceinline__ void ph_prep_wdn(const Ctx& C, const float* w_down, bf16* WDN) {
    LAS float* scr = (LAS float*)(C.lds + RING_OFF + C.wave * 16384);
    for (int it = C.gw; it < 44 * 32; it += C.NGW) { const int kb = it / 32, nb = it % 32; tr_item(w_down, DM, 64 * kb, 32 * nb, WDN, DFF, 32 * nb, 1.0f, scr, C.lane); }
}
__device__ __forceinline__ void ph_f1_naive(const Ctx& C, const bf16* H, bf16* YP) {
    build_tab(C, 128);
    const LAS float* ct = (const LAS float*)(C.lds + TAB_OFF); const LAS float* st = ct + 256;
    for (int t0 = C.gt; t0 < 8388608; t0 += C.NGT) {
        int t = t0, sq = 0; if (t >= 4194304) { sq = 2; t -= 4194304; } else if (t >= 2097152) { sq = 1; t -= 2097152; }
        int base, S, N1; seq_info(sq, base, S, N1);
        const int col = t & 511, s2 = (t >> 9) & 127, k1 = t >> 16, msk = N1 - 1, tm = 128 / N1;
        float re = 0.f, im = 0.f;
        for (int s1 = 0; s1 < N1; ++s1) {
            const float v = bf2f(H[(size_t)(base + 128 * s1 + s2) * 2048 + col]);
            const int j = ((k1 * s1) & msk) * tm;
            re += v * ct[j];
            if (k1 > 0) im -= v * st[j]; else im += v * ct[(((N1 >> 1) * s1) & msk) * tm];
        }
        const float sc = N1 == 64 ? 0.125f : 0.08838834764831845f;
        re *= sc; im *= sc;
        float yr = re, yi = im;
        if (k1 > 0) { float sn, cs; sincospif(2.0f * (float)(k1 * s2) / (float)S, &sn, &cs); yr = re * cs + im * sn; yi = im * cs - re * sn; }
        YP[(size_t)(base + (2 * k1) * 128 + s2) * 512 + col] = (bf16)f2bf(yr);
        YP[(size_t)(base + (2 * k1 + 1) * 128 + s2) * 512 + col] = (bf16)f2bf(yi);
    }
}
__device__ __forceinline__ void ph_f2_naive(const Ctx& C, const bf16* YP, bf16* H) {
    build_tab(C, 256);
    const LAS float* ct = (const LAS float*)(C.lds + TAB_OFF); const LAS float* st = ct + 256;
    for (int t0 = C.gt; t0 < 8388608; t0 += C.NGT) {
        int t = t0, sq = 0; if (t >= 4194304) { sq = 2; t -= 4194304; } else if (t >= 2097152) { sq = 1; t -= 2097152; }
        int base, S, N1; seq_info(sq, base, S, N1);
        const int col = t & 511, k2 = (t >> 9) & 127, k1 = t >> 16; const bool ctype = (col & 127) <= 64;
        const bf16* yrp = YP + (size_t)(base + (2 * k1) * 128) * 512 + col; const bf16* yip = yrp + (size_t)128 * 512;
        float a = 0.f, b = 0.f; const float sc = 0.08838834764831845f;
        if (k1 > 0) {
            for (int s2 = 0; s2 < 128; ++s2) { const float yr = bf2f(yrp[(size_t)s2 * 512]), yi = bf2f(yip[(size_t)s2 * 512]); const int j = (2 * k2 * s2) & 255; const float c = ct[j], s = st[j];
                a += c * yr + s * yi; b += s * yr - c * yi; }
            const int k = k1 + N1 * k2, km = S - k;
            if (ctype) { const bf16 o = (bf16)f2bf(a * sc); H[(size_t)(base + k) * 2048 + col] = o; H[(size_t)(base + km) * 2048 + col] = o; }
            else { H[(size_t)(base + k) * 2048 + col] = (bf16)f2bf(b * sc); H[(size_t)(base + km) * 2048 + col] = (bf16)f2bf(-b * sc); }
        } else {
            for (int s2 = 0; s2 < 128; ++s2) { const float y0 = bf2f(yrp[(size_t)s2 * 512]), yh = bf2f(yip[(size_t)s2 * 512]); const int j0 = (2 * k2 * s2) & 255, jh = ((2 * k2 + 1) * s2) & 255;
                if (ctype) { a += ct[j0] * y0; b += ct[jh] * yh; } else { a += st[j0] * y0; b += st[jh] * yh; } }
            H[(size_t)(base + N1 * k2) * 2048 + col] = (bf16)f2bf(a * sc); H[(size_t)(base + (N1 >> 1) + N1 * k2) * 2048 + col] = (bf16)f2bf(b * sc);
        }
    }
}
__device__ __forceinline__ void ph_att_naive(const Ctx& C, bf16* H, const float* rpb_l) {
    for (int t = C.gt; t < M * NH; t += C.NGT) {
        const int token = t & (M - 1), h = t >> 15, sq = token < 8192 ? 0 : (token < 16384 ? 1 : 2);
        int base, S, N1; seq_info(sq, base, S, N1);
        const int s = token - base, r = s >> 6, c = s & 63, rows = S >> 6;
        int rs = r - 4; rs = rs < 0 ? 0 : (rs > rows - 8 ? rows - 8 : rs);
        int cs = c - 8; cs = cs < 0 ? 0 : (cs > 48 ? 48 : cs);
        unsigned q[32];
        { const GAS v4u* qp = (const GAS v4u*)(H + (size_t)token * 2048 + 512 + h * 64);
#pragma unroll
          for (int i = 0; i < 8; ++i) { const v4u v = qp[i]; q[4 * i] = v.x; q[4 * i + 1] = v.y; q[4 * i + 2] = v.z; q[4 * i + 3] = v.w; } }
        float o[64];
#pragma unroll
        for (int d = 0; d < 64; ++d) o[d] = 0.f;
        float mx = -1e30f, l = 0.f;
        for (int a = 0; a < 8; ++a) for (int j = 0; j < 16; ++j) {
            const int krow = rs + a, kc = cs + j; const size_t kt = (size_t)(base + krow * 64 + kc);
            const GAS v4u* kp = (const GAS v4u*)(H + kt * 2048 + 1024 + h * 64); const GAS v4u* vp = (const GAS v4u*)(H + kt * 2048 + 1536 + h * 64);
            float dot = 0.f;
#pragma unroll
            for (int i = 0; i < 8; ++i) { const v4u kv = kp[i];
                dot += bflo(q[4 * i]) * bflo(kv.x) + bfhi(q[4 * i]) * bfhi(kv.x) + bflo(q[4 * i + 1]) * bflo(kv.y) + bfhi(q[4 * i + 1]) * bfhi(kv.y)
                     + bflo(q[4 * i + 2]) * bflo(kv.z) + bfhi(q[4 * i + 2]) * bfhi(kv.z) + bflo(q[4 * i + 3]) * bflo(kv.w) + bfhi(q[4 * i + 3]) * bfhi(kv.w); }
            const float s2 = dot + rpb_l[(h * 15 + (krow - r + 7)) * 31 + (kc - c + 15)] * LOG2E;
            const float mn = fmaxf(mx, s2), corr = __builtin_amdgcn_exp2f(mx - mn), p = __builtin_amdgcn_exp2f(s2 - mn);
            l = l * corr + p; mx = mn;
#pragma unroll
            for (int i = 0; i < 8; ++i) { const v4u vv = vp[i];
                o[8 * i + 0] = o[8 * i + 0] * corr + p * bflo(vv.x); o[8 * i + 1] = o[8 * i + 1] * corr + p * bfhi(vv.x);
                o[8 * i + 2] = o[8 * i + 2] * corr + p * bflo(vv.y); o[8 * i + 3] = o[8 * i + 3] * corr + p * bfhi(vv.y);
                o[8 * i + 4] = o[8 * i + 4] * corr + p * bflo(vv.z); o[8 * i + 5] = o[8 * i + 5] * corr + p * bfhi(vv.z);
                o[8 * i + 6] = o[8 * i + 6] * corr + p * bflo(vv.w); o[8 * i + 7] = o[8 * i + 7] * corr + p * bfhi(vv.w); }
        }
        const float il = 1.0f / l;
        GAS v4u* op = (GAS v4u*)(H + (size_t)token * 2048 + 512 + h * 64);
#pragma unroll
        for (int i = 0; i < 8; ++i) { v4u w; w.x = pk2(o[8 * i] * il, o[8 * i + 1] * il); w.y = pk2(o[8 * i + 2] * il, o[8 * i + 3] * il); w.z = pk2(o[8 * i + 4] * il, o[8 * i + 5] * il); w.w = pk2(o[8 * i + 6] * il, o[8 * i + 7] * il); op[i] = w; }
    }
}
__device__ __forceinline__ void ph_ln_naive(const Ctx& C, const float* res_p, const float* res_s, const bf16* mix, int ldmix, const float* g, const float* b, float* out, bf16* XB) {
    for (int m = C.gw; m < M; m += C.NGW) {
        const float* rsrc = res_s == nullptr ? res_p + (size_t)m * DM : (m < 16384 ? res_p + (size_t)m * DM : res_s + (size_t)(m - 16384) * DM);
        const GAS f32x4* rr = (const GAS f32x4*)rsrc + C.lane;
        const GAS unsigned long long* mr = (const GAS unsigned long long*)(mix + (size_t)m * ldmix) + C.lane;
        f32x4 v[4]; float s = 0.f;
#pragma unroll
        for (int j = 0; j < 4; ++j) { const f32x4 x = rr[64 * j]; const unsigned long long w = mr[64 * j]; const unsigned lo = (unsigned)w, hi = (unsigned)(w >> 32);
            v[j].x = ALPHA * x.x + bflo(lo); v[j].y = ALPHA * x.y + bfhi(lo); v[j].z = ALPHA * x.z + bflo(hi); v[j].w = ALPHA * x.w + bfhi(hi);
            s += (v[j].x + v[j].y) + (v[j].z + v[j].w); }
        const float mean = wave_sum(s) * (1.f / DM); float s2 = 0.f;
#pragma unroll
        for (int j = 0; j < 4; ++j) { v[j] = v[j] - mean; s2 += (v[j].x * v[j].x + v[j].y * v[j].y) + (v[j].z * v[j].z + v[j].w * v[j].w); }
        const float rstd = 1.f / sqrtf(wave_sum(s2) * (1.f / DM) + LN_EPS);
        GAS f32x4* orow = (GAS f32x4*)(out + (size_t)m * DM) + C.lane;
        GAS unsigned long long* o8 = (GAS unsigned long long*)(XB + (size_t)m * DM) + C.lane;
#pragma unroll
        for (int j = 0; j < 4; ++j) { const f32x4 gg = ((const GAS f32x4*)g)[C.lane + 64 * j], bb = ((const GAS f32x4*)b)[C.lane + 64 * j];
            const f32x4 y = v[j] * rstd * gg + bb; orow[64 * j] = y;
            o8[64 * j] = (unsigned long long)pk2(y.x, y.y) | ((unsigned long long)pk2(y.z, y.w) << 32); }
    }
}

constexpr int PH_PER_LAYER = 11, NPH = 1 + PH_PER_LAYER * DEPTH;
struct Args { const float* in[12]; float* out; unsigned char* ws; int ph_lo, ph_hi; };
__global__ void __launch_bounds__(NWAVES * 64, 2) mk_fwd(Args args) {
    extern __shared__ __attribute__((aligned(16))) unsigned char lds[];
    Ctx C; C.lds = (LAS unsigned char*)lds; C.tid = threadIdx.x; C.lane = C.tid & 63; C.wave = __builtin_amdgcn_readfirstlane(C.tid >> 6);
    const int G = gridDim.x, bx = blockIdx.x;
    C.gw = bx * NWAVES + C.wave; C.NGW = G * NWAVES; C.gt = bx * NWAVES * 64 + C.tid; C.NGT = G * NWAVES * 64;
    unsigned char* ws = args.ws;
    gu32* ctl = (gu32*)(ws + WS_CTL);
    volatile LAS unsigned* MISC = (volatile LAS unsigned*)(C.lds + MISC_OFF);
    for (int u = C.tid; u < (LDS_BYTES - LDSCTL_OFF) / 4; u += NWAVES * 64) ((LAS unsigned*)(C.lds + LDSCTL_OFF))[u] = 0u;
    __syncthreads();
    const int lo = args.ph_lo, hi = args.ph_hi;
    XcdBarrier bar; bar.bar = (unsigned*)(ctl + CW_BAR); bar.x = 0; bar.st = nullptr;
    if (hi - lo > 1) bar = xcd_barrier_post((unsigned*)(ctl + CW_BAR), MISC + 8);
    const float *xp = args.in[0], *xs = args.in[1], *w_in = args.in[2], *w_out = args.in[3], *rpb = args.in[4], *ln1_g = args.in[5], *ln1_b = args.in[6],
                *w_gate = args.in[7], *w_up = args.in[8], *w_down = args.in[9], *ln2_g = args.in[10], *ln2_b = args.in[11];
    bf16* XB = (bf16*)(ws + WS_XB); bf16* H = (bf16*)(ws + WS_H); bf16* YP = (bf16*)(ws + WS_YP); bf16* WIN = (bf16*)(ws + WS_WIN); bf16* WOUT = (bf16*)(ws + WS_WOUT);
    bf16* HID = (bf16*)(ws + WS_HID); bf16* WGU = (bf16*)(ws + WS_WGU); bf16* WDN = (bf16*)(ws + WS_WDN);
#define IN(k) (lo <= (k) && (k) < hi)
#define SEAM(k) do { if (IN(k) && IN((k) + 1)) xcd_barrier(bar); } while (0)
    if (IN(0)) { ph_convert_x(C, xp, xs, XB); ph_prep_w(C, w_in, w_out, w_gate, w_up, WIN, WOUT, WGU); }
    SEAM(0);
#define LAYER(l) do { constexpr int b = 1 + PH_PER_LAYER * (l); \
    if (IN(b + 0)) { pg8::Gemm g{XB, WIN, M, INW, DM, DM}; pg8::StaticOrder S; S.init(M, INW, G, bx); pg8::EpiBf16<0> E{H, INW, nullptr, 0, 0, 1.f}; \
        pg8::gemm_phase<pg8::EpiBf16<0>, pg8::StaticOrder, PG8_ALIGN, PG8_SP2>(C.lds + RING_OFF, g, S, E); } \
    SEAM(b + 0); \
    if (IN(b + 1)) ph_f1_naive(C, H, YP); \
    SEAM(b + 1); \
    if (IN(b + 2)) ph_att_naive(C, H, rpb + (size_t)(l) * NH * 15 * 31); \
    SEAM(b + 2); \
    if (IN(b + 3)) ph_f2_naive(C, YP, H); \
    SEAM(b + 3); \
    if (IN(b + 4)) { pg8::Gemm g{H, WOUT, M, DM, DM, INW}; pg8::StaticOrder S; S.init(M, DM, G, bx); pg8::EpiBf16<0> E{H + 1024, INW, nullptr, 0, 0, 1.f}; \
        pg8::gemm_phase<pg8::EpiBf16<0>, pg8::StaticOrder, PG8_ALIGN, PG8_SP2>(C.lds + RING_OFF, g, S, E); } \
    SEAM(b + 4); \
    if (IN(b + 5)) { if ((l) == 0) ph_ln_naive(C, xp, xs, H + 1024, INW, ln1_g, ln1_b, args.out, XB); \
        else ph_ln_naive(C, args.out, nullptr, H + 1024, INW, ln1_g + (size_t)(l) * DM, ln1_b + (size_t)(l) * DM, args.out, XB); } \
    SEAM(b + 5); \
    if (IN(b + 6)) { pg8::Gemm g{XB, WGU, M, 2 * DFF, DM, DM}; pg8::StaticOrder S; S.init(M, 2 * DFF, G, bx); pg8::EpiSwiGLU E{HID, DFF}; \
        pg8::gemm_phase<pg8::EpiSwiGLU, pg8::StaticOrder, PG8_ALIGN, PG8_SP2>(C.lds + RING_OFF, g, S, E); } \
    SEAM(b + 6); \
    if (IN(b + 7)) ph_prep_wdn(C, w_down + (size_t)(l) * DFF * DM, WDN); \
    SEAM(b + 7); \
    if (IN(b + 8)) { pg8::Gemm g{HID, WDN, M, DM, DFF, DFF}; pg8::StaticOrder S; S.init(M, DM, G, bx); pg8::EpiBf16<0> E{XB, DM, nullptr, 0, 0, 1.f}; \
        pg8::gemm_phase<pg8::EpiBf16<0>, pg8::StaticOrder, PG8_ALIGN, PG8_SP2>(C.lds + RING_OFF, g, S, E); } \
    SEAM(b + 8); \
    if (IN(b + 9)) ph_ln_naive(C, args.out, nullptr, XB, DM, ln2_g + (size_t)(l) * DM, ln2_b + (size_t)(l) * DM, args.out, XB); \
    SEAM(b + 9); \
    if ((l) + 1 < DEPTH) { if (IN(b + 10)) ph_prep_w(C, w_in + (size_t)((l) + 1) * DM * INW, w_out + (size_t)((l) + 1) * DM * DM, w_gate + (size_t)((l) + 1) * DM * DFF, w_up + (size_t)((l) + 1) * DM * DFF, WIN, WOUT, WGU); \
        SEAM(b + 10); } \
    } while (0)
    LAYER(0);
    LAYER(1);
#undef LAYER
#undef IN
#undef SEAM
}

extern "C" void kernel_launch(void* const* d_in, const int* in_sizes, int n_in, void* d_out, int out_size, void* d_ws, size_t ws_size, hipStream_t stream) {
    static int grid = 0;
    if (grid == 0) {
        if (n_in != 12 || in_sizes[0] != 2 * 8192 * DM || in_sizes[1] != 16384 * DM || out_size != M * DM || ws_size < WS_END) {
            fprintf(stderr, "kernel_launch: unexpected shapes (n_in %d, in0 %d, out %d, ws %zu); nothing launched\n", n_in, n_in > 0 ? in_sizes[0] : -1, out_size, ws_size); grid = -1; return; }
        int dev = 0, cus = 0;
        if (hipGetDevice(&dev) != hipSuccess || hipDeviceGetAttribute(&cus, hipDeviceAttributeMultiprocessorCount, dev) != hipSuccess) { grid = -1; return; }
        if (hipFuncSetAttribute((const void*)mk_fwd, hipFuncAttributeMaxDynamicSharedMemorySize, LDS_BYTES) != hipSuccess) { fprintf(stderr, "kernel_launch: hipFuncSetAttribute failed\n"); grid = -1; return; }
        (void)hipGetLastError();
        grid = cus;
    }
    if (grid < 0) return;
    (void)hipMemsetAsync((char*)d_ws + WS_CTL, 0, CTL_ZERO_BYTES, stream);
    Args a{};
    for (int i = 0; i < 12; ++i) a.in[i] = (const float*)d_in[i];
    a.out = (float*)d_out; a.ws = (unsigned char*)d_ws;
#ifndef MK_ONE_LAUNCH
    for (int ph = 0; ph < NPH - 1; ++ph) { a.ph_lo = ph; a.ph_hi = ph + 1; hipLaunchKernelGGL(mk_fwd, dim3(grid), dim3(NWAVES * 64), LDS_BYTES, stream, a); }
#else
    a.ph_lo = 0; a.ph_hi = NPH - 1; hipLaunchKernelGGL(mk_fwd, dim3(grid), dim3(NWAVES * 64), LDS_BYTES, stream, a);
#endif
}
```

```cpp
#include <hip/hip_runtime.h>
#include <cstdio>
#include <cstdint>
#define MK_ONE_LAUNCH 1
namespace pg8 {
#define PG8_LAS __attribute__((address_space(3)))
typedef unsigned short bf16_t;
typedef short bf16x8 __attribute__((ext_vector_type(8)));
typedef float f32x4 __attribute__((ext_vector_type(4)));
typedef unsigned u32x4 __attribute__((ext_vector_type(4)));
constexpr int BM = 256, BK = 64, HALF = 128, HTB = HALF * BK * 2  , STAGE_BYTES = 8 * HTB, NXCD = 8, WGM = 8;

__host__ __device__ __forceinline__ int lds_byte(int r, int c) { const int st = (r >> 4) * 2 + (c >> 5), rr = r & 15, cc = c & 31, ob = rr * 64 + cc * 2; return st * 1024 + (ob ^ (((ob >> 9) & 1) << 5)); }
__host__ __device__ __forceinline__ void stage_rc(int b, int& R, int& C) { const int st = b / 1024, sb = b % 1024, swz = sb ^ (((sb >> 9) & 1) << 5); R = (st >> 1) * 16 + swz / 64; C = (st & 1) * 32 + (swz % 64) / 2; }
__host__ __device__ __forceinline__ int perm32(int rho) { const int n = rho >> 4, i = rho & 15; return 8 * (i >> 2) + 4 * n + (i & 3); }

struct Unit { int pm, pn; };
struct Gemm { const bf16_t* A; const bf16_t* Bt; int M, N, K, lda; };

struct StaticOrder {
    int nM, nN, nwg, G, c;
    __host__ __device__ void init(int M, int N, int G_, int c_) { nM = M / BM; nN = N / BM; nwg = nM * nN; G = G_; c = c_; }
    __host__ __device__ bool next(int i, Unit& u) const {
        const long L = (long)i * G + c; if (L >= nwg) return false;
        int wgid = (int)L; { const int q = nwg / NXCD, r = nwg % NXCD, xcd = wgid % NXCD, off = wgid / NXCD; wgid = (xcd < r ? xcd * (q + 1) : r * (q + 1) + (xcd - r) * q) + off; }
        const int nig = WGM * nN, gid = wgid / nig, fm = gid * WGM, gsz = (nM - fm) < WGM ? (nM - fm) : WGM;
        u.pm = fm + ((wgid % nig) % gsz); u.pn = (wgid % nig) / gsz; return true;
    }
    __device__ __forceinline__ void a_ready(const Unit&) const {}
    __device__ __forceinline__ void done(const Unit&) const {}
};

__device__ __forceinline__ unsigned cvt_pk_bf16(float lo, float hi) { unsigned r; asm volatile("v_cvt_pk_bf16_f32 %0, %1, %2" : "=v"(r) : "v"(lo), "v"(hi)); return r; }
typedef float f32x2 __attribute__((ext_vector_type(2)));
__device__ __forceinline__ f32x2 gelu_pk(f32x2 v) {
    const f32x2 av = __builtin_elementwise_abs(v), d = av * 0.2316418882f + 1.0f;
    f32x2 t; t.x = __builtin_amdgcn_rcpf(d.x); t.y = __builtin_amdgcn_rcpf(d.y);
    f32x2 q = t * 0.5307027145f + (-0.7265760135f); q = q * t + 0.7107068705f; q = q * t + (-0.142248368f); q = q * t + 0.127414796f; q = q * t;
    const f32x2 s = (v * v) * (-0.72134752044f);
    f32x2 e; e.x = __builtin_amdgcn_exp2f(s.x); e.y = __builtin_amdgcn_exp2f(s.y);
    const f32x2 m = v * (q * e), r = v - m;
    f32x2 o; o.x = v.x < 0.f ? m.x : r.x; o.y = v.y < 0.f ? m.y : r.y; return o;
}

template <int ACT  > struct EpiBf16 {
    static constexpr bool PERM = true, AFTER_DRAIN = false; static_assert(ACT == 0 || ACT == 1, "EpiBf16: ACT is 0 (none) or 1 (gelu_pk)");
    bf16_t* O; int ldc; const float* bias; int split_cols; size_t split_stride; float scale0;
    __device__ __forceinline__ void operator()(const f32x4 (&acc)[2][2][4][2], const Unit& u, int wr, int wc, int fr, int fq) const {
        const int row0 = u.pm * BM + wr * 64 + fr; int colt = u.pn * BM; bf16_t* base = O;
        float sc = 1.f; if (split_cols) { const int t = colt / split_cols; base += (size_t)t * split_stride; colt -= t * split_cols; if (t == 0) sc = scale0; }
        const int col0 = colt + wc * 32 + 8 * fq, bcol0 = u.pn * BM + wc * 32 + 8 * fq;
        f32x4 bv[2][2];
#pragma unroll
        for (int bj = 0; bj < 2; ++bj)
#pragma unroll
            for (int n = 0; n < 2; ++n) bv[bj][n] = bias ? *(const f32x4*)(bias + bcol0 + bj * HALF + 4 * n) : (f32x4){0.f, 0.f, 0.f, 0.f};
#pragma unroll
        for (int ai = 0; ai < 2; ++ai)
#pragma unroll
            for (int m = 0; m < 4; ++m) { bf16_t* rowp = base + (size_t)(row0 + ai * HALF + m * 16) * ldc + col0;
#pragma unroll
                for (int bj = 0; bj < 2; ++bj) { f32x4 v0 = acc[ai][bj][m][0] + bv[bj][0], v1 = acc[ai][bj][m][1] + bv[bj][1];
                    if (ACT == 1) { f32x2 a = gelu_pk((f32x2){v0[0], v0[1]}), b = gelu_pk((f32x2){v0[2], v0[3]}), c = gelu_pk((f32x2){v1[0], v1[1]}), d = gelu_pk((f32x2){v1[2], v1[3]});
                        v0 = (f32x4){a.x, a.y, b.x, b.y}; v1 = (f32x4){c.x, c.y, d.x, d.y}; }
                    v0 = v0 * sc; v1 = v1 * sc; u32x4 w; w.x = cvt_pk_bf16(v0[0], v0[1]); w.y = cvt_pk_bf16(v0[2], v0[3]); w.z = cvt_pk_bf16(v1[0], v1[1]); w.w = cvt_pk_bf16(v1[2], v1[3]);
                    *(u32x4*)(rowp + bj * HALF) = w; } }
    }
};

struct PanelStats {
    unsigned* xbuf;
    unsigned* cnt;
    unsigned* tmo;
    int ntn; float eps;
    unsigned code;
    __device__ __forceinline__ bool run(const f32x4 (&v)[2][2][4][2], const Unit& u, int wr, int wc, int fr, int fq, PG8_LAS unsigned char* lds, int wid, int lane) const {
        typedef float f32x2v __attribute__((ext_vector_type(2)));
        PG8_LAS f32x2v* P = (PG8_LAS f32x2v*)lds;
        PG8_LAS f32x2v* S = (PG8_LAS f32x2v*)(lds + 8192);
        PG8_LAS unsigned* flag = (PG8_LAS unsigned*)(lds + 8192 + 2048);
#pragma unroll
        for (int ai = 0; ai < 2; ++ai)
#pragma unroll
            for (int m = 0; m < 4; ++m) {
                float s = 0.f;
#pragma unroll
                for (int bj = 0; bj < 2; ++bj)
#pragma unroll
                    for (int n = 0; n < 2; ++n) { const f32x4 x = v[ai][bj][m][n]; s += (x[0] + x[1]) + (x[2] + x[3]); }
                s += __shfl_xor(s, 16); s += __shfl_xor(s, 32);
                const float mw = s * (1.0f / 64.0f); float q = 0.f;
#pragma unroll
                for (int bj = 0; bj < 2; ++bj)
#pragma unroll
                    for (int n = 0; n < 2; ++n) { const f32x4 d = v[ai][bj][m][n] - mw; q += (d[0] * d[0] + d[1] * d[1]) + (d[2] * d[2] + d[3] * d[3]); }
                q += __shfl_xor(q, 16); q += __shfl_xor(q, 32);
                if (fq == 0) P[(ai * HALF + wr * 64 + m * 16 + fr) * 4 + wc] = (f32x2v){mw, q};
            }
        asm volatile("s_waitcnt lgkmcnt(0)" ::: "memory"); __builtin_amdgcn_s_barrier(); asm volatile("" ::: "memory");
#if defined(BROKEN_EXCHANGE_NO_WAIT)
#warning BROKEN CONTROL BUILD: the row-statistics exchange does not wait; results are wrong by design
        if (blockIdx.x >= 64) { const long long t0_ = clock64(); while (clock64() - t0_ < 60000) __builtin_amdgcn_s_sleep(8); }
#endif
        const int row = wid * 32 + (lane & 31);
        if (lane < 32) {
            const f32x2v a = P[row * 4 + 0], b = P[row * 4 + 1], c = P[row * 4 + 2], d = P[row * 4 + 3];
            const float mt = (a.x + b.x + c.x + d.x) * 0.25f;
            const float da = a.x - mt, db = b.x - mt, dc = c.x - mt, dd = d.x - mt;
            const float m2 = (a.y + b.y) + (c.y + d.y) + 64.0f * ((da * da + db * db) + (dc * dc + dd * dd));
            unsigned long long* slot = (unsigned long long*)xbuf + ((size_t)(u.pm * BM + row) * 4 + u.pn);
            __hip_atomic_store(slot, ((unsigned long long)__float_as_uint(m2) << 32) | __float_as_uint(mt), __ATOMIC_RELAXED, __HIP_MEMORY_SCOPE_AGENT);
        }
        asm volatile("s_waitcnt vmcnt(0)" ::: "memory");
        if (lane == 0) __hip_atomic_fetch_add(cnt + 64 * u.pm, 1u, __ATOMIC_RELAXED, __HIP_MEMORY_SCOPE_AGENT);
        if (wid == 0) {
            bool dead = false; const unsigned long long t0 = __builtin_amdgcn_s_memrealtime(); const unsigned want = 8u * (unsigned)ntn;
            for (;;) {
#if defined(BROKEN_EXCHANGE_NO_WAIT)
                break;
#endif
                if ((unsigned)__builtin_amdgcn_readfirstlane(__hip_atomic_load(cnt + 64 * u.pm, __ATOMIC_RELAXED, __HIP_MEMORY_SCOPE_AGENT)) >= want) break;
                if (__builtin_amdgcn_s_memrealtime() - t0 > 2000000ull) {
                    if (lane == 0) { unsigned expect = 0u; __hip_atomic_compare_exchange_strong(tmo + 1, &expect, code | (unsigned)(u.pm & 0xff), __ATOMIC_RELAXED, __ATOMIC_RELAXED, __HIP_MEMORY_SCOPE_AGENT);
                                     __hip_atomic_store(tmo, 1u, __ATOMIC_RELAXED, __HIP_MEMORY_SCOPE_AGENT); }
                    dead = true; break; }
                __builtin_amdgcn_s_sleep(2);
            }
            __builtin_amdgcn_fence(__ATOMIC_ACQUIRE, "agent");
            if (lane == 0) flag[0] = dead ? 1u : 0u;
        }
        asm volatile("s_waitcnt vmcnt(0) lgkmcnt(0)" ::: "memory"); __builtin_amdgcn_s_barrier(); asm volatile("" ::: "memory");
        const bool bad = flag[0] != 0u;
        if (lane < 32) {
            const unsigned long long* slot = (const unsigned long long*)xbuf + (size_t)(u.pm * BM + row) * 4; float mt[4], m2[4]; float ms = 0.f;
#pragma unroll
            for (int t = 0; t < 4; ++t) { if (t < ntn) { const unsigned long long w = __hip_atomic_load(slot + t, __ATOMIC_RELAXED, __HIP_MEMORY_SCOPE_AGENT); mt[t] = __uint_as_float((unsigned)w); m2[t] = __uint_as_float((unsigned)(w >> 32)); } else { mt[t] = 0.f; m2[t] = 0.f; } ms += mt[t]; }
            const float mean = ms / (float)ntn; float q = 0.f;
#pragma unroll
            for (int t = 0; t < 4; ++t) if (t < ntn) { const float dm = mt[t] - mean; q += m2[t] + 256.0f * dm * dm; }
            S[row] = (f32x2v){mean, 1.0f / sqrtf(q / (256.0f * (float)ntn) + eps)};
        }
        asm volatile("s_waitcnt lgkmcnt(0)" ::: "memory"); __builtin_amdgcn_s_barrier(); asm volatile("" ::: "memory");
        return bad;
    }
};
struct EpiLnRes {
    static constexpr bool PERM = false, AFTER_DRAIN = true;
    const float* base; float* out; int ldc; const float* bias; PanelStats st; unsigned poison;
    __device__ __forceinline__ void fused(f32x4 (&acc)[2][2][4][2], const Unit& u, int wr, int wc, int fr, int fq, PG8_LAS unsigned char* lds, int wid, int lane) const {
        typedef float f32x2v __attribute__((ext_vector_type(2)));
        const PG8_LAS f32x2v* S = (const PG8_LAS f32x2v*)(lds + 8192);
        const int col0 = u.pn * BM + wc * 32 + 4 * fq;
#pragma unroll
        for (int bj = 0; bj < 2; ++bj)
#pragma unroll
            for (int n = 0; n < 2; ++n) { const f32x4 bv = bias ? *(const f32x4*)(bias + col0 + bj * HALF + n * 16) : (f32x4){0.f, 0.f, 0.f, 0.f};
#pragma unroll
                for (int ai = 0; ai < 2; ++ai)
#pragma unroll
                    for (int m = 0; m < 4; ++m) acc[ai][bj][m][n] += bv; }
        f32x4 pre[4][2][2];
#pragma unroll
        for (int m = 0; m < 4; ++m) { const size_t off = (size_t)(u.pm * BM + wr * 64 + m * 16 + fr) * ldc + col0;
#pragma unroll
            for (int bj = 0; bj < 2; ++bj)
#pragma unroll
                for (int n = 0; n < 2; ++n) pre[m][bj][n] = *(const f32x4*)(base + off + bj * HALF + n * 16); }
        const bool bad = st.run(acc, u, wr, wc, fr, fq, lds, wid, lane) || poison != 0u;
        const float qnan = __builtin_nanf("");
#pragma unroll
        for (int ai = 0; ai < 2; ++ai)
#pragma unroll
            for (int m = 0; m < 4; ++m) { const int r = ai * HALF + wr * 64 + m * 16 + fr; const f32x2v sr = S[r]; const size_t off = (size_t)(u.pm * BM + r) * ldc + col0;
#pragma unroll
                for (int bj = 0; bj < 2; ++bj)
#pragma unroll
                    for (int n = 0; n < 2; ++n) { const f32x4 bs = ai == 0 ? pre[m][bj][n] : *(const f32x4*)(base + off + bj * HALF + n * 16); f32x4 o = bs + (acc[ai][bj][m][n] - sr.x) * sr.y;
                        if (bad) o = (f32x4){qnan, qnan, qnan, qnan}; *(f32x4*)(out + off + bj * HALF + n * 16) = o; }
                if (m & 1) asm volatile("" ::: "memory"); }
    }
};
struct EpiLnResLn {
    static constexpr bool PERM = false, AFTER_DRAIN = true;
    const float* base; float* out; bf16_t* xn; int ldc; const float* bias; PanelStats st1, st2; unsigned poison;
    __device__ __forceinline__ void fused(f32x4 (&acc)[2][2][4][2], const Unit& u, int wr, int wc, int fr, int fq, PG8_LAS unsigned char* lds, int wid, int lane) const {
        typedef float f32x2v __attribute__((ext_vector_type(2))); typedef unsigned u32x2v __attribute__((ext_vector_type(2)));
        const PG8_LAS f32x2v* S = (const PG8_LAS f32x2v*)(lds + 8192);
        const int col0 = u.pn * BM + wc * 32 + 4 * fq;
#pragma unroll
        for (int bj = 0; bj < 2; ++bj)
#pragma unroll
            for (int n = 0; n < 2; ++n) { const f32x4 bv = bias ? *(const f32x4*)(bias + col0 + bj * HALF + n * 16) : (f32x4){0.f, 0.f, 0.f, 0.f};
#pragma unroll
                for (int ai = 0; ai < 2; ++ai)
#pragma unroll
                    for (int m = 0; m < 4; ++m) acc[ai][bj][m][n] += bv; }
        bool bad = st1.run(acc, u, wr, wc, fr, fq, lds, wid, lane) || poison != 0u;
        const float qnan = __builtin_nanf("");
#pragma unroll
        for (int ai = 0; ai < 2; ++ai)
#pragma unroll
            for (int m = 0; m < 4; ++m) { const int r = ai * HALF + wr * 64 + m * 16 + fr; const f32x2v sr = S[r]; const size_t off = (size_t)(u.pm * BM + r) * ldc + col0;
#pragma unroll
                for (int bj = 0; bj < 2; ++bj)
#pragma unroll
                    for (int n = 0; n < 2; ++n) { const f32x4 bs = *(const f32x4*)(base + off + bj * HALF + n * 16); acc[ai][bj][m][n] = bs + (acc[ai][bj][m][n] - sr.x) * sr.y; }
                asm volatile("" : "+v"(acc[ai][0][m][0]), "+v"(acc[ai][0][m][1]), "+v"(acc[ai][1][m][0]), "+v"(acc[ai][1][m][1]));
                if (m & 1) asm volatile("" ::: "memory"); }
        const bool bad1 = bad;
        bad = st2.run(acc, u, wr, wc, fr, fq, lds, wid, lane) || bad;
#pragma unroll
        for (int ai = 0; ai < 2; ++ai)
#pragma unroll
            for (int m = 0; m < 4; ++m) { const int r = ai * HALF + wr * 64 + m * 16 + fr; const f32x2v sr = S[r]; const size_t off = (size_t)(u.pm * BM + r) * ldc + col0;
#pragma unroll
                for (int bj = 0; bj < 2; ++bj)
#pragma unroll
                    for (int n = 0; n < 2; ++n) { const f32x4 x1 = acc[ai][bj][m][n]; *(f32x4*)(out + off + bj * HALF + n * 16) = bad1 ? (f32x4){qnan, qnan, qnan, qnan} : x1;
                        const f32x4 o = (x1 - sr.x) * sr.y; u32x2v w; w.x = cvt_pk_bf16(o[0], o[1]); w.y = cvt_pk_bf16(o[2], o[3]);
                        if (bad) { w.x = 0x7fc07fc0u; w.y = 0x7fc07fc0u; } *(u32x2v*)(xn + off + bj * HALF + n * 16) = w; }
                asm volatile("" ::: "memory"); }
    }
};

template <class Epi, class Sched, bool ALIGN_EPI = false, bool SP2 = false>
__device__ __forceinline__ void gemm_phase(PG8_LAS unsigned char* lds, const Gemm g, const Sched& S, const Epi& E) {
    const int tid = threadIdx.x, wid = __builtin_amdgcn_readfirstlane(tid >> 6), lane = tid & 63, wr = wid >> 2, wc = wid & 3, fr = lane & 15, fq = lane >> 4;
    const int K = g.K, nt = K / BK;
    unsigned voffA[2], voffB[2];
#pragma unroll
    for (int i = 0; i < 2; ++i) { int R, C; stage_rc(tid * 16 + i * 8192, R, C); const int Rb = Epi::PERM ? ((R & ~31) + perm32(R & 31)) : R;
        voffA[i] = (unsigned)(R * g.lda + C) * 2u; voffB[i] = (unsigned)(Rb * K + C) * 2u; }
    const size_t kstep = (size_t)(BK * 2);
    const size_t hstepB = (size_t)HALF * K * 2, hstepA = (size_t)HALF * g.lda * 2;
    const size_t tstepA = 2 * hstepA, tstepB = 2 * hstepB;
    const unsigned ldsw = (unsigned)wid * 1024u;
    const int aoff = lds_byte(wr * 64 + fr, fq * 8), boff = lds_byte(wc * 32 + fr, fq * 8);
#define PG8_SA(b, h) (((b) * 2 + (h)) * HTB)
#define PG8_SB(b, h) ((4 + (b) * 2 + (h)) * HTB)
#define PG8_STAGE(bufoff, gbase, voff) do { _Pragma("unroll") for (int _i = 0; _i < 2; ++_i) \
        __builtin_amdgcn_global_load_lds((const unsigned*)((const char*)(gbase) + (voff)[_i]), (PG8_LAS unsigned*)(lds + (bufoff) + ldsw + _i * 8192), 16, 0, 0); } while (0)
#define PG8_LDA(dst, b, h) do { _Pragma("unroll") for (int m = 0; m < 4; ++m) _Pragma("unroll") for (int k = 0; k < 2; ++k) dst[m][k] = *(const PG8_LAS bf16x8*)(lds + PG8_SA(b, h) + aoff + m * 2048 + k * 1024); } while (0)
#define PG8_LDB(dst, b, h) do { _Pragma("unroll") for (int n = 0; n < 2; ++n) _Pragma("unroll") for (int k = 0; k < 2; ++k) dst[n][k] = *(const PG8_LAS bf16x8*)(lds + PG8_SB(b, h) + boff + n * 2048 + k * 1024); } while (0)
#define PG8_MMA(ai, bj, At, Bt) do { __builtin_amdgcn_s_setprio(1); _Pragma("unroll") for (int m = 0; m < 4; ++m) _Pragma("unroll") for (int n = 0; n < 2; ++n) _Pragma("unroll") for (int k = 0; k < 2; ++k) \
        acc[ai][bj][m][n] = __builtin_amdgcn_mfma_f32_16x16x32_bf16(Bt[n][k], At[m][k], acc[ai][bj][m][n], 0, 0, 0); __builtin_amdgcn_s_setprio(0); } while (0)
#define PG8_WAIT_V(n) asm volatile("s_waitcnt vmcnt(" #n ")" ::: "memory")
#define PG8_WAIT_L(n) asm volatile("s_waitcnt lgkmcnt(" #n ")" ::: "memory")
#define PG8_BAR __builtin_amdgcn_s_barrier()
#define PG8_SCHED __builtin_amdgcn_sched_barrier(0)
    Unit cur, nxt; int ui = 0;
    if (!S.next(0, cur)) return;
    f32x4 acc[2][2][4][2];
#pragma unroll
    for (int a = 0; a < 2; ++a)
#pragma unroll
        for (int b = 0; b < 2; ++b)
#pragma unroll
            for (int m = 0; m < 4; ++m)
#pragma unroll
                for (int n = 0; n < 2; ++n) acc[a][b][m][n] = (f32x4){0.f, 0.f, 0.f, 0.f};
    bf16x8 At[4][2], B0[2][2], B1[2][2];
    const char* cA = (const char*)g.A + (size_t)cur.pm * tstepA; const char* cB = (const char*)g.Bt + (size_t)cur.pn * tstepB;
    S.a_ready(cur);
    if constexpr (SP2) {
        PG8_STAGE(PG8_SB(0, 0), cB, voffB); PG8_STAGE(PG8_SB(0, 1), cB + hstepB, voffB); PG8_STAGE(PG8_SA(0, 0), cA, voffA); PG8_STAGE(PG8_SA(0, 1), cA + hstepA, voffA);
        if (wr == 1) PG8_BAR;
        PG8_WAIT_V(2); PG8_BAR;
        PG8_STAGE(PG8_SB(1, 0), cB + kstep, voffB); PG8_STAGE(PG8_SA(1, 0), cA + kstep, voffA); PG8_STAGE(PG8_SB(1, 1), cB + hstepB + kstep, voffB);
        PG8_WAIT_V(6); PG8_BAR;
    } else {
        PG8_STAGE(PG8_SB(0, 0), cB, voffB); PG8_STAGE(PG8_SA(0, 0), cA, voffA); PG8_STAGE(PG8_SB(0, 1), cB + hstepB, voffB); PG8_STAGE(PG8_SA(0, 1), cA + hstepA, voffA);
        if (wr == 1) PG8_BAR;
        PG8_WAIT_V(4); PG8_BAR;
        PG8_STAGE(PG8_SB(1, 0), cB + kstep, voffB); PG8_STAGE(PG8_SA(1, 0), cA + kstep, voffA); PG8_STAGE(PG8_SB(1, 1), cB + hstepB + kstep, voffB);
        PG8_WAIT_V(6); PG8_BAR;
    }
    for (;;) {
        const bool has_next = S.next(ui + 1, nxt);
        const char* nA = has_next ? (const char*)g.A + (size_t)nxt.pm * tstepA : cA; const char* nB = has_next ? (const char*)g.Bt + (size_t)nxt.pn * tstepB : cB;
        for (int t = 0; t < nt; t += 2) {
            const bool last = (t == nt - 2);
            const char* a1 = cA + (size_t)(t + 1) * kstep;
            const char* a2 = last ? nA : cA + (size_t)(t + 2) * kstep; const char* b2 = last ? nB : cB + (size_t)(t + 2) * kstep;
            const char* a3 = a2 + kstep; const char* b3 = b2 + kstep;
            if (last && has_next) S.a_ready(nxt);
            if constexpr (SP2) {
            PG8_LDB(B0, 0, 0); PG8_LDB(B1, 0, 1); PG8_SCHED; PG8_LDA(At, 0, 0); PG8_STAGE(PG8_SA(1, 1), a1 + hstepA, voffA);
            PG8_WAIT_V(8); PG8_WAIT_L(0); PG8_BAR; PG8_MMA(0, 0, At, B0); PG8_MMA(0, 1, At, B1); PG8_BAR; PG8_SCHED;
            PG8_LDA(At, 0, 1); PG8_STAGE(PG8_SB(0, 0), b2, voffB); PG8_STAGE(PG8_SB(0, 1), b2 + hstepB, voffB); PG8_STAGE(PG8_SA(0, 0), a2, voffA);
            PG8_WAIT_V(8); PG8_WAIT_L(0); PG8_BAR; PG8_MMA(1, 0, At, B0); PG8_MMA(1, 1, At, B1); PG8_BAR; PG8_SCHED;
            PG8_LDB(B0, 1, 0); PG8_LDB(B1, 1, 1); PG8_SCHED; PG8_LDA(At, 1, 0); PG8_STAGE(PG8_SA(0, 1), a2 + hstepA, voffA);
            PG8_WAIT_V(8); PG8_WAIT_L(0); PG8_BAR; PG8_MMA(0, 0, At, B0); PG8_MMA(0, 1, At, B1); PG8_BAR; PG8_SCHED;
            PG8_LDA(At, 1, 1); PG8_STAGE(PG8_SB(1, 0), b3, voffB); PG8_STAGE(PG8_SB(1, 1), b3 + hstepB, voffB); PG8_STAGE(PG8_SA(1, 0), a3, voffA);
            PG8_WAIT_V(8); PG8_WAIT_L(0); PG8_BAR; PG8_MMA(1, 0, At, B0); PG8_MMA(1, 1, At, B1); PG8_BAR; PG8_SCHED;
            } else {
            PG8_LDB(B0, 0, 0); PG8_SCHED; PG8_LDA(At, 0, 0); PG8_STAGE(PG8_SA(1, 1), a1 + hstepA, voffA);
            PG8_WAIT_L(8); PG8_BAR; PG8_WAIT_L(0); PG8_MMA(0, 0, At, B0); PG8_BAR; PG8_SCHED;
            PG8_LDB(B1, 0, 1); PG8_STAGE(PG8_SB(0, 0), b2, voffB);
            PG8_BAR; PG8_WAIT_L(0); PG8_MMA(0, 1, At, B1); PG8_BAR;
            PG8_LDA(At, 0, 1); PG8_STAGE(PG8_SA(0, 0), a2, voffA);
            PG8_BAR; PG8_WAIT_L(0); PG8_MMA(1, 0, At, B0); PG8_BAR; PG8_SCHED;
            PG8_STAGE(PG8_SB(0, 1), b2 + hstepB, voffB);
            PG8_WAIT_V(6); PG8_BAR; PG8_MMA(1, 1, At, B1); PG8_BAR;
            PG8_LDB(B0, 1, 0); PG8_SCHED; PG8_LDA(At, 1, 0); PG8_STAGE(PG8_SA(0, 1), a2 + hstepA, voffA);
            PG8_WAIT_L(8); PG8_BAR; PG8_WAIT_L(0); PG8_MMA(0, 0, At, B0); PG8_BAR; PG8_SCHED;
            PG8_LDB(B1, 1, 1); PG8_STAGE(PG8_SB(1, 0), b3, voffB);
            PG8_BAR; PG8_WAIT_L(0); PG8_MMA(0, 1, At, B1); PG8_BAR;
            PG8_LDA(At, 1, 1); PG8_STAGE(PG8_SA(1, 0), a3, voffA);
            PG8_BAR; PG8_WAIT_L(0); PG8_MMA(1, 0, At, B0); PG8_BAR; PG8_SCHED;
            PG8_STAGE(PG8_SB(1, 1), b3 + hstepB, voffB);
            PG8_WAIT_V(6); PG8_BAR; PG8_MMA(1, 1, At, B1); PG8_BAR;
            }
        }
        if constexpr (ALIGN_EPI) { if (wr == 0) PG8_BAR; }
        if constexpr (!Epi::AFTER_DRAIN) { E(acc, cur, wr, wc, fr, fq); S.done(cur); }
        if (!has_next) break;
#pragma unroll
        for (int a = 0; a < 2; ++a)
#pragma unroll
            for (int b = 0; b < 2; ++b)
#pragma unroll
                for (int m = 0; m < 4; ++m)
#pragma unroll
                    for (int n = 0; n < 2; ++n) acc[a][b][m][n] = (f32x4){0.f, 0.f, 0.f, 0.f};
        cur = nxt; cA = nA; cB = nB; ++ui;
        if constexpr (ALIGN_EPI) { if (wr == 1) PG8_BAR; }
    }
    PG8_WAIT_V(0);
    if constexpr (!ALIGN_EPI) { if (wr == 0) PG8_BAR; }
    PG8_BAR;
    if constexpr (Epi::AFTER_DRAIN) { E.fused(acc, cur, wr, wc, fr, fq, lds, wid, lane); S.done(cur); }
#undef PG8_SA
#undef PG8_SB
#undef PG8_STAGE
#undef PG8_LDA
#undef PG8_LDB
#undef PG8_MMA
#undef PG8_WAIT_V
#undef PG8_WAIT_L
#undef PG8_BAR
#undef PG8_SCHED
}
}
namespace pg8 {
struct EpiSwiGLU {
    static constexpr bool PERM = true, AFTER_DRAIN = false;
    bf16_t* O; int ldc;
    __device__ __forceinline__ void operator()(const f32x4 (&acc)[2][2][4][2], const Unit& u, int wr, int wc, int fr, int fq) const {
        const int row0 = u.pm * BM + wr * 64 + fr, col0 = u.pn * HALF + wc * 32 + 8 * fq;
#pragma unroll
        for (int ai = 0; ai < 2; ++ai)
#pragma unroll
            for (int m = 0; m < 4; ++m) { bf16_t* rowp = O + (size_t)(row0 + ai * HALF + m * 16) * ldc + col0;
                float h[8];
#pragma unroll
                for (int n = 0; n < 2; ++n)
#pragma unroll
                    for (int i = 0; i < 4; ++i) { const float g = acc[ai][0][m][n][i], up = acc[ai][1][m][n][i];
                        const float e = __builtin_amdgcn_exp2f(g * -1.4426950408889634f);
                        h[4 * n + i] = g * __builtin_amdgcn_rcpf(1.0f + e) * up; }
                u32x4 w; w.x = cvt_pk_bf16(h[0], h[1]); w.y = cvt_pk_bf16(h[2], h[3]); w.z = cvt_pk_bf16(h[4], h[5]); w.w = cvt_pk_bf16(h[6], h[7]);
                *(u32x4*)rowp = w; }
    }
};
}
#ifndef PG8_SP2
#define PG8_SP2 true
#endif
#ifndef PG8_ALIGN
#define PG8_ALIGN true
#endif
constexpr int DM = 1024, M = 32768, DEPTH = 2, INW = 2048, DFF = 2816, NH = 8;
constexpr float ALPHA = 1.4142135623730951f;
constexpr float LN_EPS = 1e-5f;
constexpr float LOG2E = 1.4426950408889634f;
constexpr float QSCALE = 0.125f * LOG2E;
__device__ __forceinline__ void seq_info(int sq, int& base, int& S, int& N1) { base = sq == 0 ? 0 : (sq == 1 ? 8192 : 16384); S = sq == 2 ? 16384 : 8192; N1 = S >> 7; }
constexpr size_t MiB = 1u << 20;
constexpr size_t WS_XB = 0;
constexpr size_t WS_H = 64 * MiB;
constexpr size_t WS_YP = 192 * MiB;
constexpr size_t WS_WIN = 224 * MiB;
constexpr size_t WS_WOUT = 228 * MiB;
constexpr size_t WS_HID = 64 * MiB;
constexpr size_t WS_WGU = 240 * MiB;
constexpr size_t WS_WDN = 240 * MiB;
constexpr size_t WS_CTL = 251 * MiB, CTL_ZERO_BYTES = 1 * MiB;
constexpr size_t WS_XCH = 252 * MiB;
constexpr size_t WS_END = 256 * MiB;
static_assert(WS_HID + (size_t)M * DFF * 2 <= WS_WGU && WS_WGU + (size_t)2 * DFF * DM * 2 <= WS_CTL && WS_WOUT + (size_t)DM * DM * 2 <= WS_HID + (size_t)M * DFF * 2, "ws map");
constexpr int CW_TMO = 0, CW_CODE = 1, CW_BAR = 4096;
constexpr int RING_OFF = 0, RING_BYTES = 131072;
constexpr int LDSCTL_OFF = 147456, MISC_OFF = LDSCTL_OFF + 320, ATT_BIAS_OFF = 148480;
constexpr int LDS_BYTES = 150528;
constexpr int NWAVES = 8;
#define GAS __attribute__((address_space(1)))
#define LAS __attribute__((address_space(3)))
typedef unsigned short bf16;
typedef unsigned v4u __attribute__((ext_vector_type(4)));
typedef float f32x4 __attribute__((ext_vector_type(4)));
typedef short bf16x8 __attribute__((ext_vector_type(8)));
typedef GAS unsigned gu32;
typedef GAS unsigned long long gu64;
#define RLX_AGENT __ATOMIC_RELAXED, __HIP_MEMORY_SCOPE_AGENT
#define LDS_WAIT() asm volatile("s_waitcnt lgkmcnt(0)" ::: "memory")
#define VM_WAIT() asm volatile("s_waitcnt vmcnt(0)" ::: "memory")
__device__ __forceinline__ unsigned long long rt() { return __builtin_amdgcn_s_memrealtime(); }
__device__ __forceinline__ unsigned f2bf(float f) { unsigned u = __builtin_bit_cast(unsigned, f); return (u + 0x7fffu + ((u >> 16) & 1u)) >> 16; }
__device__ __forceinline__ unsigned pk2(float lo, float hi) { return f2bf(lo) | (f2bf(hi) << 16); }

#define XB_TMO      128
#define XB_XCNT(j)  (256  + 64 * (j))
#define XB_XSUB(j)  (1280 + 64 * (j))
#define XB_XGEN(j)  (2304 + 64 * (j))
#define XB_TOP      3328
#define XB_TOPGEN   3392
#define XCD_BAR_WORDS 3456
#define XB_SPIN_CAP (1u << 18)

__device__ __forceinline__ unsigned xb_ld(unsigned* p)              { return __hip_atomic_load(p, __ATOMIC_RELAXED, __HIP_MEMORY_SCOPE_AGENT); }
__device__ __forceinline__ unsigned xb_add(unsigned* p, unsigned v) { return __hip_atomic_fetch_add(p, v, __ATOMIC_RELAXED, __HIP_MEMORY_SCOPE_AGENT); }
__device__ __forceinline__ unsigned xb_xcc_id() { return (unsigned)__builtin_amdgcn_s_getreg((3 << 11) | 20) & 0xFu; }
#define XB_SPIN(cond, bar) do { unsigned _sp = 0; while (cond) { __builtin_amdgcn_s_sleep(1); \
    if ((++_sp & 255u) == 0u) { if (xb_ld(&(bar)[XB_TMO])) break; if (_sp > XB_SPIN_CAP) { atomicAdd(&(bar)[XB_TMO], 1u); break; } } } } while (0)

struct XcdBarrier {
    unsigned* bar; unsigned x;
    volatile LAS unsigned* st;
};

__device__ __forceinline__ XcdBarrier xcd_barrier_post(unsigned* bar, volatile LAS unsigned* st) {
    XcdBarrier b; b.bar = bar; b.x = xb_xcc_id(); b.st = st;
    if (threadIdx.x == 0) (void)xb_add(&bar[XB_XCNT(b.x)], 1u);
    return b;
}
__device__ __forceinline__ void xcd_barrier_complete(unsigned* bar, unsigned x, unsigned& nloc, unsigned& nx) {
    const unsigned G = gridDim.x * gridDim.y * gridDim.z;
    unsigned sum, cnt, mine, sp = 0u;
    for (;;) {
        sum = 0u; cnt = 0u; mine = 0u;
#pragma unroll
        for (unsigned j = 0; j < 16; ++j) { const unsigned c = xb_ld(&bar[XB_XCNT(j)]); sum += c; cnt += (c > 0u) ? 1u : 0u; mine = (j == x) ? c : mine; }
        if (sum == G) break;
        __builtin_amdgcn_s_sleep(1);
        if ((++sp & 255u) == 0u) { if (xb_ld(&bar[XB_TMO])) break; if (sp > XB_SPIN_CAP) { atomicAdd(&bar[XB_TMO], 1u); break; } }
    }
    nloc = mine > 0u ? mine : 1u; nx = cnt > 0u ? cnt : 1u;
}

__device__ __forceinline__ void xcd_barrier(const XcdBarrier& b) {
    asm volatile("s_waitcnt vmcnt(0)" ::: "memory");
    __syncthreads();
    if (threadIdx.x == 0) {
        unsigned* bar = b.bar;
        __builtin_amdgcn_s_waitcnt(0);
        unsigned nloc = b.st[0], nx = b.st[1];
        if (nloc == 0u) { xcd_barrier_complete(bar, b.x, nloc, nx); b.st[0] = nloc; b.st[1] = nx; }
        const unsigned old = xb_add(&bar[XB_XSUB(b.x)], 1u);
        const unsigned gen = old / nloc;
        if (old + 1u == (gen + 1u) * nloc) {
            __builtin_amdgcn_fence(__ATOMIC_RELEASE, "agent");
            asm volatile("s_waitcnt vmcnt(0)" ::: "memory");
            const unsigned og = xb_add(&bar[XB_TOP], 1u);
            const unsigned tg = og / nx;
            if (og + 1u == (tg + 1u) * nx) xb_add(&bar[XB_TOPGEN], 1u);
            else XB_SPIN(xb_ld(&bar[XB_TOPGEN]) == tg, bar);
            __builtin_amdgcn_fence(__ATOMIC_ACQUIRE, "agent");
            xb_add(&bar[XB_XGEN(b.x)], 1u);
            asm volatile("s_waitcnt vmcnt(0)" ::: "memory");
        } else {
            XB_SPIN(xb_ld(&bar[XB_XGEN(b.x)]) == gen, bar);
            __builtin_amdgcn_fence(__ATOMIC_ACQUIRE, "agent");
            asm volatile("s_waitcnt vmcnt(0)" ::: "memory");
        }
    }
    __syncthreads();
}

__device__ __forceinline__ float bf2f(unsigned b) { return __uint_as_float(b << 16); }
__device__ __forceinline__ float bflo(unsigned w) { return __uint_as_float(w << 16); }
__device__ __forceinline__ float bfhi(unsigned w) { return __uint_as_float(w & 0xffff0000u); }
__device__ __forceinline__ float wave_sum(float v) {
#pragma unroll
    for (int o = 1; o < 64; o <<= 1) v += __shfl_xor(v, o);
    return v;
}
struct Ctx { LAS unsigned char* lds; int tid, lane, wave, gw, NGW, gt, NGT; };

__device__ __forceinline__ void ph_convert_x(const Ctx& C, const float* xp, const float* xs, bf16* XN) {
    for (int m = C.gw; m < M; m += C.NGW) {
        const float* src = m < 16384 ? xp + (size_t)m * DM : xs + (size_t)(m - 16384) * DM;
        const GAS f32x4* xr = (const GAS f32x4*)src + C.lane;
        GAS unsigned long long* o8 = (GAS unsigned long long*)(XN + (size_t)m * DM) + C.lane;
#pragma unroll
        for (int j = 0; j < 4; ++j) { const f32x4 v = xr[64 * j]; o8[64 * j] = (unsigned long long)pk2(v.x, v.y) | ((unsigned long long)pk2(v.z, v.w) << 32); }
    }
}
__device__ __forceinline__ void tr_item(const float* W, int ldw, int k0, int n0, bf16* WT, int ldt, int drow0, float scale, LAS float* scr, int lane) {
#pragma unroll 8
    for (int i = 0; i < 32; ++i) { const int kk = 2 * i + (lane >> 5); scr[kk * 33 + (lane & 31)] = W[(size_t)(k0 + kk) * ldw + n0 + (lane & 31)]; }
    LDS_WAIT(); asm volatile("" ::: "memory");
    const int c = lane & 7;
#pragma unroll
    for (int j = 0; j < 4; ++j) { const int n = (lane >> 3) + 8 * j; const LAS float* s = scr + (8 * c) * 33 + n;
        v4u o; o.x = pk2(s[0 * 33] * scale, s[1 * 33] * scale); o.y = pk2(s[2 * 33] * scale, s[3 * 33] * scale); o.z = pk2(s[4 * 33] * scale, s[5 * 33] * scale); o.w = pk2(s[6 * 33] * scale, s[7 * 33] * scale);
        *(GAS v4u*)(WT + (size_t)(drow0 + n) * ldt + k0 + 8 * c) = o; }
    LDS_WAIT(); asm volatile("" ::: "memory");
}
constexpr int TAB_OFF = 126976;
__device__ __forceinline__ void build_tab(const Ctx& C, int n) {
    LAS float* ct = (LAS float*)(C.lds + TAB_OFF); LAS float* st = ct + 256;
    for (int j = C.tid; j < n; j += NWAVES * 64) { float s, c; sincospif(2.0f * (float)j / (float)n, &s, &c); ct[j] = c; st[j] = s; }
    __syncthreads();
}
__device__ __forceinline__ void ph_prep_w(const Ctx& C, const float* w_in, const float* w_out, const float* w_gate, const float* w_up, bf16* WIN, bf16* WOUT, bf16* WGU) {
    build_tab(C, 128);
    const LAS float* ct = (const LAS float*)(C.lds + TAB_OFF); const LAS float* st = ct + 256;
    LAS float* scr = (LAS float*)(C.lds + RING_OFF + C.wave * 16384);
    constexpr int I_QKV = 16 * 48, I_WO = 8 * 32, I_G = 16 * 88, I_E = 1024 * 4, I_F = (1024 * 512) / 64;
    constexpr int NIT = I_QKV + I_WO + 2 * I_G + I_E + I_F;
    for (int it = C.gw; it < NIT; it += C.NGW) {
        int r = it;
        if (r < I_QKV) { const int kb = r / 48, nb = r % 48, n0 = 512 + 32 * nb; tr_item(w_in, INW, 64 * kb, n0, WIN, DM, n0, n0 < 1024 ? QSCALE : 1.0f, scr, C.lane); continue; } r -= I_QKV;
        if (r < I_WO) { const int kb = r / 32, nb = r % 32; tr_item(w_out, DM, 512 + 64 * kb, 32 * nb, WOUT, DM, 32 * nb, 1.0f, scr, C.lane); continue; } r -= I_WO;
        if (r < I_G) { const int kb = r / 88, nb = r % 88, n0 = 32 * nb; tr_item(w_gate, DFF, 64 * kb, n0, WGU, DM, 256 * (n0 >> 7) + (n0 & 127), 1.0f, scr, C.lane); continue; } r -= I_G;
        if (r < I_G) { const int kb = r / 88, nb = r % 88, n0 = 32 * nb; tr_item(w_up, DFF, 64 * kb, n0, WGU, DM, 256 * (n0 >> 7) + 128 + (n0 & 127), 1.0f, scr, C.lane); continue; } r -= I_G;
        if (r < I_E) {
            const int k = r >> 2, gi = r & 3; const float* wr = w_in + (size_t)k * INW + gi * 128;
            float a0 = 0.f, a1 = 0.f;
            for (int c = 0; c < 128; ++c) { const float w = wr[c]; a0 += w * ct[(C.lane * c) & 127]; a1 += w * (C.lane == 0 ? ct[(64 * c) & 127] : st[(C.lane * c) & 127]); }
            const float sc = 0.08838834764831845f;
            WIN[(size_t)(gi * 128 + C.lane) * DM + k] = (bf16)f2bf(a0 * sc); WIN[(size_t)(gi * 128 + 64 + C.lane) * DM + k] = (bf16)f2bf(a1 * sc);
            continue; } r -= I_E;
        {
            const int t = r * 64 + C.lane, n = t >> 9, kk = t & 511, gi = kk >> 7, slot = kk & 127; const float* wb = w_out + (size_t)(gi * 128) * DM + n;
            float v;
            if (slot == 0) v = wb[0];
            else if (slot < 64) v = wb[(size_t)slot * DM] + wb[(size_t)(128 - slot) * DM];
            else if (slot == 64) v = wb[(size_t)64 * DM];
            else { const int m = slot - 64; v = wb[(size_t)(128 - m) * DM] - wb[(size_t)m * DM]; }
            WOUT[(size_t)n * DM + kk] = (bf16)f2bf(v);
        }
    }
}
__device__ __forceinline__ void ph_prep_wdn(const Ctx& C, const float* w_down, bf16* WDN) {
    LAS float* scr = (LAS float*)(C.lds + RING_OFF + C.wave * 16384);
    for (int it = C.gw; it < 44 * 32; it += C.NGW) { const int kb = it / 32, nb = it % 32; tr_item(w_down, DM, 64 * kb, 32 * nb, WDN, DFF, 32 * nb, 1.0f, scr, C.lane); }
}
__device__ __forceinline__ void ph_f1_naive(const Ctx& C, const bf16* H, bf16* YP) {
    build_tab(C, 128);
    const LAS float* ct = (const LAS float*)(C.lds + TAB_OFF); const LAS float* st = ct + 256;
    for (int t0 = C.gt; t0 < 8388608; t0 += C.NGT) {
        int t = t0, sq = 0; if (t >= 4194304) { sq = 2; t -= 4194304; } else if (t >= 2097152) { sq = 1; t -= 2097152; }
        int base, S, N1; seq_info(sq, base, S, N1);
        const int col = t & 511, s2 = (t >> 9) & 127, k1 = t >> 16, msk = N1 - 1, tm = 128 / N1;
        float re = 0.f, im = 0.f;
        for (int s1 = 0; s1 < N1; ++s1) {
            const float v = bf2f(H[(size_t)(base + 128 * s1 + s2) * 2048 + col]);
            const int j = ((k1 * s1) & msk) * tm;
            re += v * ct[j];
            if (k1 > 0) im -= v * st[j]; else im += v * ct[(((N1 >> 1) * s1) & msk) * tm];
        }
        const float sc = N1 == 64 ? 0.125f : 0.08838834764831845f;
        re *= sc; im *= sc;
        float yr = re, yi = im;
        if (k1 > 0) { float sn, cs; sincospif(2.0f * (float)(k1 * s2) / (float)S, &sn, &cs); yr = re * cs + im * sn; yi = im * cs - re * sn; }
        YP[(size_t)(base + (2 * k1) * 128 + s2) * 512 + col] = (bf16)f2bf(yr);
        YP[(size_t)(base + (2 * k1 + 1) * 128 + s2) * 512 + col] = (bf16)f2bf(yi);
    }
}
__device__ __forceinline__ void ph_f2_naive(const Ctx& C, const bf16* YP, bf16* H) {
    build_tab(C, 256);
    const LAS float* ct = (const LAS float*)(C.lds + TAB_OFF); const LAS float* st = ct + 256;
    for (int t0 = C.gt; t0 < 8388608; t0 += C.NGT) {
        int t = t0, sq = 0; if (t >= 4194304) { sq = 2; t -= 4194304; } else if (t >= 2097152) { sq = 1; t -= 2097152; }
        int base, S, N1; seq_info(sq, base, S, N1);
        const int col = t & 511, k2 = (t >> 9) & 127, k1 = t >> 16; const bool ctype = (col & 127) <= 64;
        const bf16* yrp = YP + (size_t)(base + (2 * k1) * 128) * 512 + col; const bf16* yip = yrp + (size_t)128 * 512;
        float a = 0.f, b = 0.f; const float sc = 0.08838834764831845f;
        if (k1 > 0) {
            for (int s2 = 0; s2 < 128; ++s2) { const float yr = bf2f(yrp[(size_t)s2 * 512]), yi = bf2f(yip[(size_t)s2 * 512]); const int j = (2 * k2 * s2) & 255; const float c = ct[j], s = st[j];
                a += c * yr + s * yi; b += s * yr - c * yi; }
            const int k = k1 + N1 * k2, km = S - k;
            if (ctype) { const bf16 o = (bf16)f2bf(a * sc); H[(size_t)(base + k) * 2048 + col] = o; H[(size_t)(base + km) * 2048 + col] = o; }
            else { H[(size_t)(base + k) * 2048 + col] = (bf16)f2bf(b * sc); H[(size_t)(base + km) * 2048 + col] = (bf16)f2bf(-b * sc); }
        } else {
            for (int s2 = 0; s2 < 128; ++s2) { const float y0 = bf2f(yrp[(size_t)s2 * 512]), yh = bf2f(yip[(size_t)s2 * 512]); const int j0 = (2 * k2 * s2) & 255, jh = ((2 * k2 + 1) * s2) & 255;
                if (ctype) { a += ct[j0] * y0; b += ct[jh] * yh; } else { a += st[j0] * y0; b += st[jh] * yh; } }
            H[(size_t)(base + N1 * k2) * 2048 + col] = (bf16)f2bf(a * sc); H[(size_t)(base + (N1 >> 1) + N1 * k2) * 2048 + col] = (bf16)f2bf(b * sc);
        }
    }
}
__device__ __forceinline__ void ph_att_naive(const Ctx& C, bf16* H, const float* rpb_l) {
    for (int t = C.gt; t < M * NH; t += C.NGT) {
        const int token = t & (M - 1), h = t >> 15, sq = token < 8192 ? 0 : (token < 16384 ? 1 : 2);
        int base, S, N1; seq_info(sq, base, S, N1);
        const int s = token - base, r = s >> 6, c = s & 63, rows = S >> 6;
        int rs = r - 4; rs = rs < 0 ? 0 : (rs > rows - 8 ? rows - 8 : rs);
        int cs = c - 8; cs = cs < 0 ? 0 : (cs > 48 ? 48 : cs);
        unsigned q[32];
        { const GAS v4u* qp = (const GAS v4u*)(H + (size_t)token * 2048 + 512 + h * 64);
#pragma unroll
          for (int i = 0; i < 8; ++i) { const v4u v = qp[i]; q[4 * i] = v.x; q[4 * i + 1] = v.y; q[4 * i + 2] = v.z; q[4 * i + 3] = v.w; } }
        float o[64];
#pragma unroll
        for (int d = 0; d < 64; ++d) o[d] = 0.f;
        float mx = -1e30f, l = 0.f;
        for (int a = 0; a < 8; ++a) for (int j = 0; j < 16; ++j) {
            const int krow = rs + a, kc = cs + j; const size_t kt = (size_t)(base + krow * 64 + kc);
            const GAS v4u* kp = (const GAS v4u*)(H + kt * 2048 + 1024 + h * 64); const GAS v4u* vp = (const GAS v4u*)(H + kt * 2048 + 1536 + h * 64);
            float dot = 0.f;
#pragma unroll
            for (int i = 0; i < 8; ++i) { const v4u kv = kp[i];
                dot += bflo(q[4 * i]) * bflo(kv.x) + bfhi(q[4 * i]) * bfhi(kv.x) + bflo(q[4 * i + 1]) * bflo(kv.y) + bfhi(q[4 * i + 1]) * bfhi(kv.y)
                     + bflo(q[4 * i + 2]) * bflo(kv.z) + bfhi(q[4 * i + 2]) * bfhi(kv.z) + bflo(q[4 * i + 3]) * bflo(kv.w) + bfhi(q[4 * i + 3]) * bfhi(kv.w); }
            const float s2 = dot + rpb_l[(h * 15 + (krow - r + 7)) * 31 + (kc - c + 15)] * LOG2E;
            const float mn = fmaxf(mx, s2), corr = __builtin_amdgcn_exp2f(mx - mn), p = __builtin_amdgcn_exp2f(s2 - mn);
            l = l * corr + p; mx = mn;
#pragma unroll
            for (int i = 0; i < 8; ++i) { const v4u vv = vp[i];
                o[8 * i + 0] = o[8 * i + 0] * corr + p * bflo(vv.x); o[8 * i + 1] = o[8 * i + 1] * corr + p * bfhi(vv.x);
                o[8 * i + 2] = o[8 * i + 2] * corr + p * bflo(vv.y); o[8 * i + 3] = o[8 * i + 3] * corr + p * bfhi(vv.y);
                o[8 * i + 4] = o[8 * i + 4] * corr + p * bflo(vv.z); o[8 * i + 5] = o[8 * i + 5] * corr + p * bfhi(vv.z);
                o[8 * i + 6] = o[8 * i + 6] * corr + p * bflo(vv.w); o[8 * i + 7] = o[8 * i + 7] * corr + p * bfhi(vv.w); }
        }
        const float il = 1.0f / l;
        GAS v4u* op = (GAS v4u*)(H + (size_t)token * 2048 + 512 + h * 64);
#pragma unroll
        for (int i = 0; i < 8; ++i) { v4u w; w.x = pk2(o[8 * i] * il, o[8 * i + 1] * il); w.y = pk2(o[8 * i + 2] * il, o[8 * i + 3] * il); w.z = pk2(o[8 * i + 4] * il, o[8 * i + 5] * il); w.w = pk2(o[8 * i + 6] * il, o[8 * i + 7] * il); op[i] = w; }
    }
}
__device__ __forceinline__ void ph_ln_naive(const Ctx& C, const float* res_p, const float* res_s, const bf16* mix, int ldmix, const float* g, const float* b, float* out, bf16* XB) {
    for (int m = C.gw; m < M; m += C.NGW) {
        const float* rsrc = res_s == nullptr ? res_p + (size_t)m * DM : (m < 16384 ? res_p + (size_t)m * DM : res_s + (size_t)(m - 16384) * DM);
        const GAS f32x4* rr = (const GAS f32x4*)rsrc + C.lane;
        const GAS unsigned long long* mr = (const GAS unsigned long long*)(mix + (size_t)m * ldmix) + C.lane;
        f32x4 v[4]; float s = 0.f;
#pragma unroll
        for (int j = 0; j < 4; ++j) { const f32x4 x = rr[64 * j]; const unsigned long long w = mr[64 * j]; const unsigned lo = (unsigned)w, hi = (unsigned)(w >> 32);
            v[j].x = ALPHA * x.x + bflo(lo); v[j].y = ALPHA * x.y + bfhi(lo); v[j].z = ALPHA * x.z + bflo(hi); v[j].w = ALPHA * x.w + bfhi(hi);
            s += (v[j].x + v[j].y) + (v[j].z + v[j].w); }
        const float mean = wave_sum(s) * (1.f / DM); float s2 = 0.f;
#pragma unroll
        for (int j = 0; j < 4; ++j) { v[j] = v[j] - mean; s2 += (v[j].x * v[j].x + v[j].y * v[j].y) + (v[j].z * v[j].z + v[j].w * v[j].w); }
        const float rstd = 1.f / sqrtf(wave_sum(s2) * (1.f / DM) + LN_EPS);
        GAS f32x4* orow = (GAS f32x4*)(out + (size_t)m * DM) + C.lane;
        GAS unsigned long long* o8 = (GAS unsigned long long*)(XB + (size_t)m * DM) + C.lane;
#pragma unroll
        for (int j = 0; j < 4; ++j) { const f32x4 gg = ((const GAS f32x4*)g)[C.lane + 64 * j], bb = ((const GAS f32x4*)b)[C.lane + 64 * j];
            const f32x4 y = v[j] * rstd * gg + bb; orow[64 * j] = y;
            o8[64 * j] = (unsigned long long)pk2(y.x, y.y) | ((unsigned long long)pk2(y.z, y.w) << 32); }
    }
}

typedef short att_v4i16 __attribute__((ext_vector_type(4)));
constexpr int ATT_K_OFF = 0, ATT_V_OFF = 73728, ATT_UNITS = 2048;
__device__ __forceinline__ void ph_att(const Ctx& C, bf16* H, const float* rpb_l, int bx, int G) {
    const int lane = C.lane, w = C.wave, li = lane & 15, g = lane >> 4;
    const int rw = w >> 2, jb = w & 3, c0 = 16 * jb, ks = jb == 0 ? 0 : (jb == 1 ? 8 : (jb == 2 ? 24 : 32));
    LAS float* bl = (LAS float*)(C.lds + ATT_BIAS_OFF);
    const int cq = c0 + li; int csq = cq - 8; csq = csq < 0 ? 0 : (csq > 48 ? 48 : csq);
    bool valid[2][4]; int boff[2][4];
#pragma unroll
    for (int kb = 0; kb < 2; ++kb)
#pragma unroll
        for (int i = 0; i < 4; ++i) { const int kc = ks + 16 * kb + 4 * g + i; valid[kb][i] = (kc >= csq) && (kc < csq + 16); int dc = kc - cq + 15; dc = dc < 0 ? 0 : (dc > 30 ? 30 : dc); boff[kb][i] = dc; }
    const int per = (ATT_UNITS + G - 1) / G; const int u0 = bx * per, u1 = (u0 + per) < ATT_UNITS ? (u0 + per) : ATT_UNITS;
    for (int u = u0; u < u1; ++u) {
        int sq, h, rp;
        if (u < 512) { sq = 0; h = u >> 6; rp = u & 63; } else if (u < 1024) { sq = 1; h = (u - 512) >> 6; rp = u & 63; } else { sq = 2; h = (u - 1024) >> 7; rp = u & 127; }
        int base, S, N1; seq_info(sq, base, S, N1);
        const int rows = S >> 6, r0 = 2 * rp;
        int rs0 = r0 - 4; rs0 = rs0 < 0 ? 0 : (rs0 > rows - 8 ? rows - 8 : rs0);
        int rs1 = r0 - 3; rs1 = rs1 < 0 ? 0 : (rs1 > rows - 8 ? rows - 8 : rs1);
        __syncthreads();
#pragma unroll
        for (int t = 0; t < 18; ++t) {
            const int n = w * 18 + t, isv = n >= 72, nn = isv ? n - 72 : n;
            const int tt = 8 * nn + (lane >> 3), ti = tt >> 6, tc = tt & 63;
            int gr = rs0 + ti; gr = gr > rows - 1 ? rows - 1 : gr;
            const int cp = lane & 7, c = isv ? (cp ^ (((tt >> 1) & 3) << 1)) : (cp ^ ((tt >> 1) & 7));
            const bf16* src = H + (size_t)(base + gr * 64 + tc) * 2048 + (isv ? 1536 : 1024) + h * 64 + 8 * c;
            __builtin_amdgcn_global_load_lds((const unsigned*)src, (LAS unsigned*)(C.lds + (isv ? ATT_V_OFF : ATT_K_OFF) + nn * 1024), 16, 0, 0);
        }
        if (C.tid < 480) { const int dr = C.tid >> 5, dc = C.tid & 31; bl[C.tid] = dc < 31 ? rpb_l[(h * 15 + dr) * 31 + dc] * LOG2E : 0.f; }
        const int r = r0 + rw, a0 = rw ? (rs1 - rs0) : 0, rs = rs0 + a0;
        const size_t qtok = (size_t)(base + r * 64 + c0 + li);
        bf16* qp = H + qtok * 2048 + 512 + h * 64;
        pg8::bf16x8 qf[2];
        qf[0] = *(const GAS pg8::bf16x8*)(qp + 8 * g); qf[1] = *(const GAS pg8::bf16x8*)(qp + 32 + 8 * g);
        asm volatile("s_waitcnt vmcnt(0)" ::: "memory");
        __syncthreads();
        f32x4 sa[8][2];
#pragma unroll
        for (int a = 0; a < 8; ++a)
#pragma unroll
            for (int kb = 0; kb < 2; ++kb) {
                const int tt = (a0 + a) * 64 + ks + 16 * kb + li; const int sw = (tt >> 1) & 7;
                const LAS unsigned char* kp = C.lds + ATT_K_OFF + tt * 128;
                const pg8::bf16x8 k0 = *(const LAS pg8::bf16x8*)(kp + ((g ^ sw) << 4)), k1 = *(const LAS pg8::bf16x8*)(kp + (((4 + g) ^ sw) << 4));
                f32x4 acc = (f32x4){0.f, 0.f, 0.f, 0.f};
                acc = __builtin_amdgcn_mfma_f32_16x16x32_bf16(k0, qf[0], acc, 0, 0, 0);
                acc = __builtin_amdgcn_mfma_f32_16x16x32_bf16(k1, qf[1], acc, 0, 0, 0);
                sa[a][kb] = acc;
            }
        float mx = -1e30f;
#pragma unroll
        for (int a = 0; a < 8; ++a) { const LAS float* br = bl + (rs + a - r + 7) * 32;
#pragma unroll
            for (int kb = 0; kb < 2; ++kb)
#pragma unroll
                for (int i = 0; i < 4; ++i) { const float s = valid[kb][i] ? sa[a][kb][i] + br[boff[kb][i]] : -1e30f; sa[a][kb][i] = s; mx = fmaxf(mx, s); } }
        mx = fmaxf(mx, __shfl_xor(mx, 16)); mx = fmaxf(mx, __shfl_xor(mx, 32));
        float ls = 0.f;
#pragma unroll
        for (int a = 0; a < 8; ++a)
#pragma unroll
            for (int kb = 0; kb < 2; ++kb)
#pragma unroll
                for (int i = 0; i < 4; ++i) { const float p = __builtin_amdgcn_exp2f(sa[a][kb][i] - mx); sa[a][kb][i] = p; ls += p; }
        ls += __shfl_xor(ls, 16); ls += __shfl_xor(ls, 32);
        f32x4 oa[4];
#pragma unroll
        for (int db = 0; db < 4; ++db) oa[db] = (f32x4){0.f, 0.f, 0.f, 0.f};
        const int q4 = li >> 2, p4 = li & 3;
#pragma unroll
        for (int a = 0; a < 8; ++a) {
            pg8::u32x4 pw; pw.x = pg8::cvt_pk_bf16(sa[a][0][0], sa[a][0][1]); pw.y = pg8::cvt_pk_bf16(sa[a][0][2], sa[a][0][3]); pw.z = pg8::cvt_pk_bf16(sa[a][1][0], sa[a][1][1]); pw.w = pg8::cvt_pk_bf16(sa[a][1][2], sa[a][1][3]);
            const pg8::bf16x8 pf = __builtin_bit_cast(pg8::bf16x8, pw);
            const int t0 = (a0 + a) * 64 + ks + 4 * g + q4, t1 = t0 + 16;
            const LAS unsigned char* v0p = C.lds + ATT_V_OFF + t0 * 128 + 8 * p4; const LAS unsigned char* v1p = C.lds + ATT_V_OFF + t1 * 128 + 8 * p4;
            const int s0 = (t0 >> 1) & 3, s1 = (t1 >> 1) & 3;
#pragma unroll
            for (int db = 0; db < 4; ++db) {
                const att_v4i16 lo = __builtin_amdgcn_ds_read_tr16_b64_v4i16((LAS att_v4i16*)(v0p + ((db ^ s0) << 5)));
                const att_v4i16 hi = __builtin_amdgcn_ds_read_tr16_b64_v4i16((LAS att_v4i16*)(v1p + ((db ^ s1) << 5)));
                const pg8::bf16x8 vf = (pg8::bf16x8){lo[0], lo[1], lo[2], lo[3], hi[0], hi[1], hi[2], hi[3]};
                oa[db] = __builtin_amdgcn_mfma_f32_16x16x32_bf16(vf, pf, oa[db], 0, 0, 0);
            }
        }
        const float il = 1.0f / ls;
#pragma unroll
        for (int db = 0; db < 4; ++db) {
            const unsigned long long o = (unsigned long long)pg8::cvt_pk_bf16(oa[db][0] * il, oa[db][1] * il) | ((unsigned long long)pg8::cvt_pk_bf16(oa[db][2] * il, oa[db][3] * il) << 32);
            *(GAS unsigned long long*)(qp + 16 * db + 4 * g) = o;
        }
    }
    __syncthreads();
}

constexpr size_t WS_TAB = 253 * MiB;
constexpr size_t TB_W1_64 = 0, TB_W1_128 = 8192, TB_TW_64 = 65536, TB_TW_128 = 131072, TB_W2C = 262144, TB_W2S = TB_W2C + 65536, TB_W0BC = TB_W2S + 65536, TB_W0BS = TB_W0BC + 65536;
static_assert(WS_TAB + TB_W0BS + 65536 <= WS_END, "tables");
__device__ __forceinline__ void ph_tables(const Ctx& C, unsigned char* tab) {
    for (int t = C.gt; t < 64 * 64 + 128 * 128; t += C.NGT) {
        const bool big = t >= 4096; const int N = big ? 128 : 64, e = big ? t - 4096 : t, rho = e / N, s1 = e % N, k1 = rho >> 1;
        float v;
        if (rho == 0) v = 1.0f; else if (rho == 1) v = (s1 & 1) ? -1.0f : 1.0f;
        else { float sn, cs; sincospif(2.0f * (float)((k1 * s1) % N) / (float)N, &sn, &cs); v = (rho & 1) ? -sn : cs; }
        v *= big ? 0.08838834764831845f : 0.125f;
        ((bf16*)(tab + (big ? TB_W1_128 : TB_W1_64)))[e] = (bf16)f2bf(v);
    }
    for (int t = C.gt; t < 32 * 128 + 64 * 128; t += C.NGT) {
        const bool big = t >= 4096; const int e = big ? t - 4096 : t, k1 = e >> 7, s2 = e & 127; const float S = big ? 16384.f : 8192.f;
        float sn, cs; sincospif(2.0f * (float)(k1 * s2) / S, &sn, &cs);
        ((float*)(tab + (big ? TB_TW_128 : TB_TW_64)))[2 * e] = cs; ((float*)(tab + (big ? TB_TW_128 : TB_TW_64)))[2 * e + 1] = sn;
    }
    for (int t = C.gt; t < 128 * 256; t += C.NGT) {
        const int k2 = t >> 8, kk = t & 255, s2 = kk & 127; const bool im = kk >= 128; const float sc = 0.08838834764831845f;
        float sn, cs, snh, csh; sincospif(2.0f * (float)((k2 * s2) & 127) / 128.f, &sn, &cs); sincospif((float)(((2 * k2 + 1) * s2) & 255) / 128.f, &snh, &csh);
        ((bf16*)(tab + TB_W2C))[t] = (bf16)f2bf((im ? sn : cs) * sc);
        ((bf16*)(tab + TB_W2S))[t] = (bf16)f2bf((im ? -cs : sn) * sc);
        ((bf16*)(tab + TB_W0BC))[t] = (bf16)f2bf(im ? csh * sc : 0.f);
        ((bf16*)(tab + TB_W0BS))[t] = (bf16)f2bf(im ? snh * sc : 0.f);
    }
}
__device__ __forceinline__ void ph_f1(const Ctx& C, const bf16* H, bf16* YP, const unsigned char* tab, int bx, int G) {
    const int lane = C.lane, w = C.wave, li = lane & 15, g = lane >> 4, q4 = li >> 2, p4 = li & 3;
    for (int u = bx; u < 1536; u += G) {
        const int sq = u < 1024 ? (u >> 9) : 2, rem = u < 1024 ? (u & 511) : (u - 1024), s2 = rem >> 2, gi = rem & 3;
        int base, S, N1; seq_info(sq, base, S, N1);
        const bool big = N1 == 128;
        __syncthreads();
        for (int nn = w; nn < (N1 >> 2); nn += NWAVES) {
            const int r = 4 * nn + (lane >> 4), cp = lane & 15, sw = (r & 3) | (((r >> 3) & 1) << 2), c = ((((cp >> 1) ^ sw)) << 1) | (cp & 1);
            const bf16* src = H + (size_t)(base + 128 * r + s2) * 2048 + gi * 128 + 8 * c;
            __builtin_amdgcn_global_load_lds((const unsigned*)src, (LAS unsigned*)(C.lds + nn * 1024), 16, 0, 0);
        }
        asm volatile("s_waitcnt vmcnt(0)" ::: "memory");
        __syncthreads();
        const bf16* W1 = (const bf16*)(tab + (big ? TB_W1_128 : TB_W1_64));
        const float* TW = (const float*)(tab + (big ? TB_TW_128 : TB_TW_64));
        const int nkt = N1 >> 5, nnb = N1 >> 4;
        f32x4 acc[8];
#pragma unroll
        for (int nb = 0; nb < 8; ++nb) acc[nb] = (f32x4){0.f, 0.f, 0.f, 0.f};
#pragma unroll
        for (int kt = 0; kt < 4; ++kt) if (kt < nkt) {
            const int rA = 32 * kt + 8 * g + q4, rB = rA + 4;
            const int sA = (rA & 3) | (((rA >> 3) & 1) << 2), sB = (rB & 3) | (((rB >> 3) & 1) << 2);
            const att_v4i16 lo = __builtin_amdgcn_ds_read_tr16_b64_v4i16((LAS att_v4i16*)(C.lds + rA * 256 + ((w ^ sA) << 5) + 8 * p4));
            const att_v4i16 hi = __builtin_amdgcn_ds_read_tr16_b64_v4i16((LAS att_v4i16*)(C.lds + rB * 256 + ((w ^ sB) << 5) + 8 * p4));
            const pg8::bf16x8 af = (pg8::bf16x8){lo[0], lo[1], lo[2], lo[3], hi[0], hi[1], hi[2], hi[3]};
#pragma unroll
            for (int nb = 0; nb < 8; ++nb) if (nb < nnb) {
                const pg8::bf16x8 bf = *(const GAS pg8::bf16x8*)(W1 + (size_t)(16 * nb + li) * N1 + 32 * kt + 8 * g);
                acc[nb] = __builtin_amdgcn_mfma_f32_16x16x32_bf16(af, bf, acc[nb], 0, 0, 0);
            }
        }
#pragma unroll
        for (int nb = 0; nb < 8; ++nb) if (nb < nnb) {
            const int rho = 16 * nb + li, k1 = rho >> 1; const bool odd = rho & 1;
            const float cs = TW[2 * (k1 * 128 + s2)], sn = TW[2 * (k1 * 128 + s2) + 1];
            float o[4];
#pragma unroll
            for (int i = 0; i < 4; ++i) { const float v = acc[nb][i], pv = __shfl_xor(v, 1); o[i] = odd ? v * cs - pv * sn : v * cs + pv * sn; }
            const unsigned long long ow = (unsigned long long)pg8::cvt_pk_bf16(o[0], o[1]) | ((unsigned long long)pg8::cvt_pk_bf16(o[2], o[3]) << 32);
            *(GAS unsigned long long*)(YP + (size_t)(base + rho * 128 + s2) * 512 + gi * 128 + 16 * w + 4 * g) = ow;
        }
    }
    __syncthreads();
}
__device__ __forceinline__ void ph_f2(const Ctx& C, const bf16* YP, bf16* H, const unsigned char* tab, int bx, int G) {
    const int lane = C.lane, w = C.wave, li = lane & 15, g = lane >> 4, q4 = li >> 2, p4 = li & 3;
    for (int u = bx; u < 1024; u += G) {
        const int combo = u >> 3, cb = u & 7, sq = combo < 32 ? 0 : (combo < 64 ? 1 : 2), k1 = sq == 2 ? combo - 64 : (combo & 31);
        int base, S, N1; seq_info(sq, base, S, N1);
        const bool stype = cb & 1;
        __syncthreads();
        for (int nn = w; nn < 32; nn += NWAVES) {
            const int r = 8 * nn + (lane >> 3), cp = lane & 7, sw = ((r >> 1) & 1) | (((r >> 3) & 1) << 1), c = (((cp >> 1) ^ sw) << 1) | (cp & 1);
            const bf16* src = YP + (size_t)(base + 256 * k1 + r) * 512 + cb * 64 + 8 * c;
            __builtin_amdgcn_global_load_lds((const unsigned*)src, (LAS unsigned*)(C.lds + nn * 1024), 16, 0, 0);
        }
        asm volatile("s_waitcnt vmcnt(0)" ::: "memory");
        __syncthreads();
        const int npass = k1 == 0 ? 2 : 1;
        for (int ps = 0; ps < npass; ++ps) {
            const int kt0 = (k1 == 0 && ps == 1) ? 4 : 0, kt1 = (k1 == 0 && ps == 0) ? 4 : 8;
            const bf16* TM = (const bf16*)(tab + (ps == 1 ? (stype ? TB_W0BS : TB_W0BC) : (stype ? TB_W2S : TB_W2C)));
            const bf16* TC = (const bf16*)(tab + (ps == 1 ? TB_W0BC : TB_W2C));
            f32x4 acc[4], accx = (f32x4){0.f, 0.f, 0.f, 0.f};
#pragma unroll
            for (int mb = 0; mb < 4; ++mb) acc[mb] = (f32x4){0.f, 0.f, 0.f, 0.f};
            for (int kt = kt0; kt < kt1; ++kt) {
                const pg8::bf16x8 bfm = *(const GAS pg8::bf16x8*)(TM + (size_t)(16 * w + li) * 256 + 32 * kt + 8 * g);
                const pg8::bf16x8 bfc = *(const GAS pg8::bf16x8*)(TC + (size_t)(16 * w + li) * 256 + 32 * kt + 8 * g);
                const int rA = 32 * kt + 8 * g + q4, rB = rA + 4;
                const int sA = ((rA >> 1) & 1) | (((rA >> 3) & 1) << 1), sB = ((rB >> 1) & 1) | (((rB >> 3) & 1) << 1);
#pragma unroll
                for (int mb = 0; mb < 4; ++mb) {
                    const att_v4i16 lo = __builtin_amdgcn_ds_read_tr16_b64_v4i16((LAS att_v4i16*)(C.lds + rA * 128 + ((mb ^ sA) << 5) + 8 * p4));
                    const att_v4i16 hi = __builtin_amdgcn_ds_read_tr16_b64_v4i16((LAS att_v4i16*)(C.lds + rB * 128 + ((mb ^ sB) << 5) + 8 * p4));
                    const pg8::bf16x8 af = (pg8::bf16x8){lo[0], lo[1], lo[2], lo[3], hi[0], hi[1], hi[2], hi[3]};
                    acc[mb] = __builtin_amdgcn_mfma_f32_16x16x32_bf16(af, bfm, acc[mb], 0, 0, 0);
                    if (mb == 0) accx = __builtin_amdgcn_mfma_f32_16x16x32_bf16(af, bfc, accx, 0, 0, 0);
                }
            }
            const int k2 = 16 * w + li;
            int tok, tokm; bool mirror;
            if (k1 == 0) { tok = (ps == 0 ? 0 : (N1 >> 1)) + N1 * k2; tokm = tok; mirror = false; } else { tok = k1 + N1 * k2; tokm = S - tok; mirror = true; }
#pragma unroll
            for (int mb = 0; mb < 4; ++mb) {
                float v[4], vm[4];
#pragma unroll
                for (int i = 0; i < 4; ++i) { v[i] = acc[mb][i]; vm[i] = stype ? -v[i] : v[i]; }
                if (stype && mb == 0 && g == 0) { v[0] = accx[0]; vm[0] = accx[0]; }
                const int col = cb * 64 + 16 * mb + 4 * g;
                *(GAS unsigned long long*)(H + (size_t)(base + tok) * 2048 + col) = (unsigned long long)pg8::cvt_pk_bf16(v[0], v[1]) | ((unsigned long long)pg8::cvt_pk_bf16(v[2], v[3]) << 32);
                if (mirror) *(GAS unsigned long long*)(H + (size_t)(base + tokm) * 2048 + col) = (unsigned long long)pg8::cvt_pk_bf16(vm[0], vm[1]) | ((unsigned long long)pg8::cvt_pk_bf16(vm[2], vm[3]) << 32);
            }
        }
    }
    __syncthreads();
}

constexpr int PH_PER_LAYER = 11, NPH = 1 + PH_PER_LAYER * DEPTH;
struct Args { const float* in[12]; float* out; unsigned char* ws; int ph_lo, ph_hi; };
__global__ void __launch_bounds__(NWAVES * 64, 2) mk_fwd(Args args) {
    extern __shared__ __attribute__((aligned(16))) unsigned char lds[];
    Ctx C; C.lds = (LAS unsigned char*)lds; C.tid = threadIdx.x; C.lane = C.tid & 63; C.wave = __builtin_amdgcn_readfirstlane(C.tid >> 6);
    const int G = gridDim.x, bx = blockIdx.x;
    C.gw = bx * NWAVES + C.wave; C.NGW = G * NWAVES; C.gt = bx * NWAVES * 64 + C.tid; C.NGT = G * NWAVES * 64;
    unsigned char* ws = args.ws;
    gu32* ctl = (gu32*)(ws + WS_CTL);
    volatile LAS unsigned* MISC = (volatile LAS unsigned*)(C.lds + MISC_OFF);
    for (int u = C.tid; u < (LDS_BYTES - LDSCTL_OFF) / 4; u += NWAVES * 64) ((LAS unsigned*)(C.lds + LDSCTL_OFF))[u] = 0u;
    __syncthreads();
    const int lo = args.ph_lo, hi = args.ph_hi;
    XcdBarrier bar; bar.bar = (unsigned*)(ctl + CW_BAR); bar.x = 0; bar.st = nullptr;
    if (hi - lo > 1) bar = xcd_barrier_post((unsigned*)(ctl + CW_BAR), MISC + 8);
    const float *xp = args.in[0], *xs = args.in[1], *w_in = args.in[2], *w_out = args.in[3], *rpb = args.in[4], *ln1_g = args.in[5], *ln1_b = args.in[6],
                *w_gate = args.in[7], *w_up = args.in[8], *w_down = args.in[9], *ln2_g = args.in[10], *ln2_b = args.in[11];
    bf16* XB = (bf16*)(ws + WS_XB); bf16* H = (bf16*)(ws + WS_H); bf16* YP = (bf16*)(ws + WS_YP); bf16* WIN = (bf16*)(ws + WS_WIN); bf16* WOUT = (bf16*)(ws + WS_WOUT);
    bf16* HID = (bf16*)(ws + WS_HID); bf16* WGU = (bf16*)(ws + WS_WGU); bf16* WDN = (bf16*)(ws + WS_WDN);
#define IN(k) (lo <= (k) && (k) < hi)
#define SEAM(k) do { if (IN(k) && IN((k) + 1)) xcd_barrier(bar); } while (0)
    if (IN(0)) { ph_tables(C, ws + WS_TAB); ph_convert_x(C, xp, xs, XB); ph_prep_w(C, w_in, w_out, w_gate, w_up, WIN, WOUT, WGU); }
    SEAM(0);
#define LAYER(l) do { constexpr int b = 1 + PH_PER_LAYER * (l); \
    if (IN(b + 0)) { pg8::Gemm g{XB, WIN, M, INW, DM, DM}; pg8::StaticOrder S; S.init(M, INW, G, bx); pg8::EpiBf16<0> E{H, INW, nullptr, 0, 0, 1.f}; \
        pg8::gemm_phase<pg8::EpiBf16<0>, pg8::StaticOrder, PG8_ALIGN, PG8_SP2>(C.lds + RING_OFF, g, S, E); } \
    SEAM(b + 0); \
    if (IN(b + 1)) ph_f1(C, H, YP, ws + WS_TAB, bx, G); \
    SEAM(b + 1); \
    if (IN(b + 2)) ph_att(C, H, rpb + (size_t)(l) * NH * 15 * 31, bx, G); \
    SEAM(b + 2); \
    if (IN(b + 3)) ph_f2(C, YP, H, ws + WS_TAB, bx, G); \
    SEAM(b + 3); \
    if (IN(b + 4)) { pg8::Gemm g{H, WOUT, M, DM, DM, INW}; pg8::StaticOrder S; S.init(M, DM, G, bx); pg8::EpiBf16<0> E{H + 1024, INW, nullptr, 0, 0, 1.f}; \
        pg8::gemm_phase<pg8::EpiBf16<0>, pg8::StaticOrder, PG8_ALIGN, PG8_SP2>(C.lds + RING_OFF, g, S, E); } \
    SEAM(b + 4); \
    if (IN(b + 5)) { if ((l) == 0) ph_ln_naive(C, xp, xs, H + 1024, INW, ln1_g, ln1_b, args.out, XB); \
        else ph_ln_naive(C, args.out, nullptr, H + 1024, INW, ln1_g + (size_t)(l) * DM, ln1_b + (size_t)(l) * DM, args.out, XB); } \
    SEAM(b + 5); \
    if (IN(b + 6)) { pg8::Gemm g{XB, WGU, M, 2 * DFF, DM, DM}; pg8::StaticOrder S; S.init(M, 2 * DFF, G, bx); pg8::EpiSwiGLU E{HID, DFF}; \
        pg8::gemm_phase<pg8::EpiSwiGLU, pg8::StaticOrder, PG8_ALIGN, PG8_SP2>(C.lds + RING_OFF, g, S, E); } \
    SEAM(b + 6); \
    if (IN(b + 7)) ph_prep_wdn(C, w_down + (size_t)(l) * DFF * DM, WDN); \
    SEAM(b + 7); \
    if (IN(b + 8)) { pg8::Gemm g{HID, WDN, M, DM, DFF, DFF}; pg8::StaticOrder S; S.init(M, DM, G, bx); pg8::EpiBf16<0> E{XB, DM, nullptr, 0, 0, 1.f}; \
        pg8::gemm_phase<pg8::EpiBf16<0>, pg8::StaticOrder, PG8_ALIGN, PG8_SP2>(C.lds + RING_OFF, g, S, E); } \
    SEAM(b + 8); \
    if (IN(b + 9)) ph_ln_naive(C, args.out, nullptr, XB, DM, ln2_g + (size_t)(l) * DM, ln2_b + (size_t)(l) * DM, args.out, XB); \
    SEAM(b + 9); \
    if ((l) + 1 < DEPTH) { if (IN(b + 10)) ph_prep_w(C, w_in + (size_t)((l) + 1) * DM * INW, w_out + (size_t)((l) + 1) * DM * DM, w_gate + (size_t)((l) + 1) * DM * DFF, w_up + (size_t)((l) + 1) * DM * DFF, WIN, WOUT, WGU); \
        SEAM(b + 10); } \
    } while (0)
    LAYER(0);
    LAYER(1);
#undef LAYER
#undef IN
#undef SEAM
}

extern "C" void kernel_launch(void* const* d_in, const int* in_sizes, int n_in, void* d_out, int out_size, void* d_ws, size_t ws_size, hipStream_t stream) {
    static int grid = 0;
    if (grid == 0) {
        if (n_in != 12 || in_sizes[0] != 2 * 8192 * DM || in_sizes[1] != 16384 * DM || out_size != M * DM || ws_size < WS_END) {
            fprintf(stderr, "kernel_launch: unexpected shapes (n_in %d, in0 %d, out %d, ws %zu); nothing launched\n", n_in, n_in > 0 ? in_sizes[0] : -1, out_size, ws_size); grid = -1; return; }
        int dev = 0, cus = 0;
        if (hipGetDevice(&dev) != hipSuccess || hipDeviceGetAttribute(&cus, hipDeviceAttributeMultiprocessorCount, dev) != hipSuccess) { grid = -1; return; }
        if (hipFuncSetAttribute((const void*)mk_fwd, hipFuncAttributeMaxDynamicSharedMemorySize, LDS_BYTES) != hipSuccess) { fprintf(stderr, "kernel_launch: hipFuncSetAttribute failed\n"); grid = -1; return; }
        (void)hipGetLastError();
        grid = cus;
    }
    if (grid < 0) return;
    (void)hipMemsetAsync((char*)d_ws + WS_CTL, 0, CTL_ZERO_BYTES, stream);
    Args a{};
    for (int i = 0; i < 12; ++i) a.in[i] = (const float*)d_in[i];
    a.out = (float*)d_out; a.ws = (unsigned char*)d_ws;
#ifndef MK_ONE_LAUNCH
    for (int ph = 0; ph < NPH - 1; ++ph) { a.ph_lo = ph; a.ph_hi = ph + 1; hipLaunchKernelGGL(mk_fwd, dim3(grid), dim3(NWAVES * 64), LDS_BYTES, stream, a); }
#else
    a.ph_lo = 0; a.ph_hi = NPH - 1; hipLaunchKernelGGL(mk_fwd, dim3(grid), dim3(NWAVES * 64), LDS_BYTES, stream, a);
#endif
}
```
